# Optimizing an MI355X kernel written in HIP

```python
import math
import jax, jax.numpy as jnp
from jax import lax
import numpy as np

D_MODEL = 1024
BATCH = 2
SEQ = 16384
DEPTH = 4

N_A = DEPTH // 2
N_B = DEPTH - N_A
MEM_TOKENS = 256
MEM_HEADS = 4
MEM_DH = D_MODEL // 16
MEM_W = MEM_HEADS * MEM_DH
DN_DK = 128
DN_DV = 128
DN_HEADS = (3 * D_MODEL) // (4 * DN_DV)
DN_QK_W = DN_HEADS * DN_DK
DN_V_W = DN_HEADS * DN_DV
CONV_WIDTH = 4
CHUNK = 64
SWA_DH = 64
SWA_HEADS = (3 * D_MODEL) // (4 * SWA_DH)
SWA_KV_HEADS = 2
SWA_GROUP = SWA_HEADS // SWA_KV_HEADS
SWA_Q_W = SWA_HEADS * SWA_DH
SWA_KV_W = SWA_KV_HEADS * SWA_DH
WINDOW = 128
ROPE_THETA = 10000.0
MLP_HIDDEN = 4 * D_MODEL
LN_EPS = 1e-5
NORM_EPS = 1e-6
DN_ALPHA = (2.0 * DEPTH) ** 0.25
DN_BETA = (8.0 * DEPTH) ** -0.25
A_IN = 2 * DN_QK_W + 2 * DN_V_W + 2 * DN_HEADS + MEM_W
B_IN = SWA_Q_W + MEM_W
MIX_W = DN_V_W + MEM_W

kernel_name = "yoco_deltanet_swa_sink_memory_trunk"


def layer_norm(x, g, b):
    xf = x.astype(jnp.float32)
    mu = jnp.mean(xf, axis=-1, keepdims=True)
    var = jnp.mean(jnp.square(xf - mu), axis=-1, keepdims=True)
    y = (xf - mu) * lax.rsqrt(var + LN_EPS) * g.astype(jnp.float32) + b.astype(jnp.float32)
    return y.astype(x.dtype)


def l2_normalize(x):
    xf = x.astype(jnp.float32)
    return xf * lax.rsqrt(jnp.sum(xf * xf, axis=-1, keepdims=True) + NORM_EPS)


def rope_tables(positions, dh):
    inv_freq = ROPE_THETA ** (-jnp.arange(0, dh, 2, dtype=jnp.float32) / dh)
    ang = positions.astype(jnp.float32)[..., None] * inv_freq
    return jnp.cos(ang)[:, :, None, :], jnp.sin(ang)[:, :, None, :]


def apply_rope(x, cos, sin):
    xf = x.astype(jnp.float32)
    x1, x2 = jnp.split(xf, 2, axis=-1)
    out = jnp.concatenate([x1 * cos - x2 * sin, x2 * cos + x1 * sin], axis=-1)
    return out.astype(x.dtype)


def causal_depthwise_conv(x, w):
    C = x.shape[-1]
    return lax.conv_general_dilated(
        x, w[:, None, :].astype(x.dtype), window_strides=(1,),
        padding=[(CONV_WIDTH - 1, 0)], dimension_numbers=('NWC', 'WIO', 'NWC'),
        feature_group_count=C)


def gated_delta_rule(q, k, v, g, beta):
    B, S, H, DK = q.shape
    DV = v.shape[-1]
    N = S // CHUNK
    f32 = jnp.float32

    def to_chunks(t):
        t = t.astype(f32).reshape((B, N, CHUNK, H) + t.shape[3:])
        return jnp.moveaxis(t, 3, 1)

    q = to_chunks(q) * (DK ** -0.5)
    k = to_chunks(k)
    v = to_chunks(v)
    beta = to_chunks(beta)
    g = jnp.cumsum(to_chunks(g), axis=-1)
    incl = jnp.tril(jnp.ones((CHUNK, CHUNK), bool))
    strict = jnp.tril(jnp.ones((CHUNK, CHUNK), bool), -1)
    decay = jnp.exp(jnp.where(incl, g[..., :, None] - g[..., None, :], -jnp.inf))
    k_beta = k * beta[..., None]
    L = jnp.where(strict, jnp.einsum('bhnid,bhnjd->bhnij', k_beta, k) * decay, 0.0)
    rhs = jnp.concatenate([v * beta[..., None], k_beta * jnp.exp(g)[..., None]], axis=-1)
    sol = lax.linalg.triangular_solve(L, rhs, left_side=True, lower=True, unit_diagonal=True)
    u, w = sol[..., :DV], sol[..., DV:]
    intra = jnp.where(incl, jnp.einsum('bhnid,bhnjd->bhnij', q, k) * decay, 0.0)
    q_dec = q * jnp.exp(g)[..., None]
    k_dec = k * jnp.exp(g[..., -1:] - g)[..., None]
    chunk_decay = jnp.exp(g[..., -1])

    def step(state, inp):
        qd, kd, uc, wc, ac, cd = inp
        v_new = uc - jnp.einsum('bhik,bhkv->bhiv', wc, state)
        out = jnp.einsum('bhik,bhkv->bhiv', qd, state) + jnp.einsum('bhij,bhjv->bhiv', ac, v_new)
        state = state * cd[..., None, None] + jnp.einsum('bhik,bhiv->bhkv', kd, v_new)
        return state, out

    xs = (jnp.moveaxis(q_dec, 2, 0), jnp.moveaxis(k_dec, 2, 0), jnp.moveaxis(u, 2, 0),
          jnp.moveaxis(w, 2, 0), jnp.moveaxis(intra, 2, 0), jnp.moveaxis(chunk_decay, 2, 0))
    s0 = jnp.zeros((B, H, DK, DV), f32)
    _, out = lax.scan(step, s0, xs)
    return jnp.transpose(out, (1, 0, 3, 2, 4)).reshape(B, S, H, DV)


def sliding_window_sink_attention(q, k, v, sinks):
    B, S, HKV, G, dh = q.shape
    NB = S // WINDOW
    qb = q.reshape(B, NB, WINDOW, HKV, G, dh)

    def band_keys(t):
        tb = t.reshape(B, NB, WINDOW, HKV, dh)
        prev = jnp.pad(tb, ((0, 0), (1, 0), (0, 0), (0, 0), (0, 0)))[:, :-1]
        return jnp.concatenate([prev, tb], axis=2)

    kk = band_keys(k)
    vv = band_keys(v)
    s = jnp.einsum('bnqhgd,bnkhd->bnhgqk', qb, kk).astype(jnp.float32) * (dh ** -0.5)
    qi = jnp.arange(WINDOW)[:, None]
    kj = jnp.arange(2 * WINDOW)[None, :]
    diff = qi + WINDOW - kj
    band = (diff >= 0) & (diff < WINDOW)
    key_pos = jnp.arange(NB)[:, None] * WINDOW - WINDOW + kj
    valid = band[None] & (key_pos >= 0)[:, None, :]
    s = jnp.where(valid[None, :, None, None], s, -jnp.inf)
    sink = sinks.astype(jnp.float32).reshape(HKV, G)[None, None, :, :, None, None]
    m = jnp.maximum(jnp.max(s, axis=-1, keepdims=True), sink)
    p = jnp.exp(s - m)
    denom = jnp.sum(p, axis=-1, keepdims=True) + jnp.exp(sink - m)
    probs = (p / denom).astype(v.dtype)
    o = jnp.einsum('bnhgqk,bnkhd->bnqhgd', probs, vv)
    return o.reshape(B, S, HKV * G * dh)


def memory_cross_attention(qm, mem, w_kv):
    B, S, _ = qm.shape
    M = mem.shape[1]
    kv = mem @ w_kv
    k = kv[..., :MEM_W].reshape(B, M, MEM_HEADS, MEM_DH)
    v = kv[..., MEM_W:].reshape(B, M, MEM_HEADS, MEM_DH)
    q = qm.reshape(B, S, MEM_HEADS, MEM_DH)
    s = jnp.einsum('bshd,bmhd->bhsm', q, k).astype(jnp.float32) * (MEM_DH ** -0.5)
    p = jax.nn.softmax(s, axis=-1).astype(v.dtype)
    return jnp.einsum('bhsm,bmhd->bshd', p, v).reshape(B, S, MEM_W)


def mixer_a(h, mem, w_in, conv_w, A_log, dt_bias, norm_w, mem_w_kv, w_o):
    B, S, _ = h.shape
    proj = h @ w_in
    c1 = 2 * DN_QK_W + DN_V_W
    qkv = proj[..., :c1]
    z = proj[..., c1:c1 + DN_V_W]
    a = proj[..., c1 + DN_V_W:c1 + DN_V_W + DN_HEADS]
    b = proj[..., c1 + DN_V_W + DN_HEADS:c1 + DN_V_W + 2 * DN_HEADS]
    qm = proj[..., c1 + DN_V_W + 2 * DN_HEADS:]
    qkv = jax.nn.silu(causal_depthwise_conv(qkv, conv_w))
    q = l2_normalize(qkv[..., :DN_QK_W].reshape(B, S, DN_HEADS, DN_DK))
    k = l2_normalize(qkv[..., DN_QK_W:2 * DN_QK_W].reshape(B, S, DN_HEADS, DN_DK))
    v = qkv[..., 2 * DN_QK_W:].reshape(B, S, DN_HEADS, DN_DV)
    beta = jax.nn.sigmoid(b.astype(jnp.float32))
    g = -jnp.exp(A_log.astype(jnp.float32)) * jax.nn.softplus(a.astype(jnp.float32) + dt_bias.astype(jnp.float32))
    o = gated_delta_rule(q, k, v, g, beta)
    o = o * lax.rsqrt(jnp.mean(o * o, axis=-1, keepdims=True) + NORM_EPS) * norm_w.astype(jnp.float32)
    o = o * jax.nn.silu(z.astype(jnp.float32).reshape(B, S, DN_HEADS, DN_DV))
    o = o.astype(h.dtype).reshape(B, S, DN_V_W)
    mo = memory_cross_attention(qm, mem, mem_w_kv)
    return jnp.concatenate([o, mo], axis=-1) @ w_o


def mixer_b(h, mem, k_sh, v_sh, cos, sin, w_in, sinks, mem_w_kv, w_o):
    B, S, _ = h.shape
    proj = h @ w_in
    q = apply_rope(proj[..., :SWA_Q_W].reshape(B, S, SWA_HEADS, SWA_DH), cos, sin)
    q = q.reshape(B, S, SWA_KV_HEADS, SWA_GROUP, SWA_DH)
    o = sliding_window_sink_attention(q, k_sh, v_sh, sinks)
    mo = memory_cross_attention(proj[..., SWA_Q_W:], mem, mem_w_kv)
    return jnp.concatenate([o, mo], axis=-1) @ w_o


def shared_kv(h, w_kv, cos, sin):
    B, S, _ = h.shape
    kv = h @ w_kv
    k = apply_rope(kv[..., :SWA_KV_W].reshape(B, S, SWA_KV_HEADS, SWA_DH), cos, sin)
    v = kv[..., SWA_KV_W:].reshape(B, S, SWA_KV_HEADS, SWA_DH)
    return k, v


def sq_relu_mlp(h, w_up, w_down):
    return jnp.square(jax.nn.relu(h @ w_up)) @ w_down


def setup_inputs(seed: int = 0) -> dict:
    key = jax.random.key(seed)
    ks = jax.random.split(key, 20)
    f32 = jnp.float32

    def dense(k, shape, fan_in, scale=1.0):
        return jax.random.normal(k, shape, f32) * (fan_in ** -0.5) * scale

    x = jax.random.normal(ks[0], (BATCH, SEQ, D_MODEL), f32)
    mem = jax.random.normal(ks[1], (BATCH, MEM_TOKENS, D_MODEL), f32)
    positions = (jax.random.randint(ks[2], (BATCH, 1), 0, 4096, jnp.int32)
                 + jnp.arange(SEQ, dtype=jnp.int32)[None, :])
    a_w_in = dense(ks[3], (N_A, D_MODEL, A_IN), D_MODEL)
    a_conv_w = jax.random.normal(ks[4], (N_A, CONV_WIDTH, 2 * DN_QK_W + DN_V_W), f32) * (CONV_WIDTH ** -0.5)
    a_A_log = jnp.log(jax.random.uniform(ks[5], (N_A, DN_HEADS), f32, 1.0, 16.0))
    dt = jnp.exp(jax.random.uniform(ks[6], (N_A, DN_HEADS), f32, math.log(1e-3), math.log(1e-1)))
    a_dt_bias = dt + jnp.log(-jnp.expm1(-dt))
    a_norm_w = 1.0 + 0.02 * jax.random.normal(ks[7], (N_A, DN_DV), f32)
    b_w_in = dense(ks[8], (N_B, D_MODEL, B_IN), D_MODEL)
    b_sinks = 0.5 * jax.random.normal(ks[9], (N_B, SWA_HEADS), f32)
    w_kv_shared = dense(ks[10], (D_MODEL, 2 * SWA_KV_W), D_MODEL)
    mem_w_kv = dense(ks[11], (DEPTH, D_MODEL, 2 * MEM_W), D_MODEL)
    w_o = dense(ks[12], (DEPTH, MIX_W, D_MODEL), MIX_W, DN_BETA)
    mlp_w_up = dense(ks[13], (DEPTH, D_MODEL, MLP_HIDDEN), D_MODEL)
    mlp_w_down = dense(ks[14], (DEPTH, MLP_HIDDEN, D_MODEL), MLP_HIDDEN, DN_BETA)
    ln_g = 1.0 + 0.02 * jax.random.normal(ks[15], (DEPTH, 2, D_MODEL), f32)
    ln_b = 0.02 * jax.random.normal(ks[16], (DEPTH, 2, D_MODEL), f32)
    return {"x": x, "mem": mem, "positions": positions, "a_w_in": a_w_in, "a_conv_w": a_conv_w,
            "a_A_log": a_A_log, "a_dt_bias": a_dt_bias, "a_norm_w": a_norm_w, "b_w_in": b_w_in,
            "b_sinks": b_sinks, "w_kv_shared": w_kv_shared, "mem_w_kv": mem_w_kv, "w_o": w_o,
            "mlp_w_up": mlp_w_up, "mlp_w_down": mlp_w_down, "ln_g": ln_g, "ln_b": ln_b}


def reference(x, mem, positions, a_w_in, a_conv_w, a_A_log, a_dt_bias, a_norm_w, b_w_in,
              b_sinks, w_kv_shared, mem_w_kv, w_o, mlp_w_up, mlp_w_down, ln_g, ln_b):
    cos, sin = rope_tables(positions, SWA_DH)
    h = x
    k_sh = None
    v_sh = None
    for layer in range(DEPTH):
        if layer < N_A:
            mix = mixer_a(h, mem, a_w_in[layer], a_conv_w[layer], a_A_log[layer], a_dt_bias[layer],
                          a_norm_w[layer], mem_w_kv[layer], w_o[layer])
        else:
            j = layer - N_A
            mix = mixer_b(h, mem, k_sh, v_sh, cos, sin, b_w_in[j], b_sinks[j], mem_w_kv[layer], w_o[layer])
        h = layer_norm(DN_ALPHA * h + mix, ln_g[layer, 0], ln_b[layer, 0])
        h = layer_norm(DN_ALPHA * h + sq_relu_mlp(h, mlp_w_up[layer], mlp_w_down[layer]),
                       ln_g[layer, 1], ln_b[layer, 1])
        if layer == N_A - 1:
            k_sh, v_sh = shared_kv(h, w_kv_shared, cos, sin)
    return h
```

```cpp
#include <hip/hip_runtime.h>
#include <hip/hip_cooperative_groups.h>
#include <cstdio>
namespace cg = cooperative_groups;
#define DI __device__ __forceinline__
typedef unsigned short bf16_t;
typedef short bf16x8 __attribute__((ext_vector_type(8)));
typedef float f32x4 __attribute__((ext_vector_type(4)));
typedef float f32x2 __attribute__((ext_vector_type(2)));
typedef unsigned u32x4 __attribute__((ext_vector_type(4)));
typedef unsigned u32x2 __attribute__((ext_vector_type(2)));
typedef __bf16 bf16x2_t __attribute__((ext_vector_type(2)));
DI unsigned pk2(float lo, float hi) { f32x2 v = {lo, hi}; bf16x2_t b = __builtin_convertvector(v, bf16x2_t); return __builtin_bit_cast(unsigned, b); }
DI float bf2f(unsigned short b) { return __uint_as_float(((unsigned)b) << 16); }
DI float bflo(unsigned w) { return __uint_as_float(w << 16); }
DI float bfhi(unsigned w) { return __uint_as_float(w & 0xffff0000u); }
DI unsigned short f2bf(float f) { return (unsigned short)(pk2(f, 0.f) & 0xffffu); }
#define MFMA16(a, b, c) __builtin_amdgcn_mfma_f32_16x16x32_bf16((a), (b), (c), 0, 0, 0)
DI float wave_sum(float v) {
#pragma unroll
    for (int o = 1; o < 64; o <<= 1) v += __shfl_xor(v, o);
    return v;
}
DI int opaque_tid() { int t = (int)threadIdx.x; asm volatile("" : "+v"(t)); return t; }
DI int opaque_s(int v) { v = __builtin_amdgcn_readfirstlane(v); asm volatile("" : "+s"(v)); return v; }
template <class Tp> DI Tp* opaque_ptr(Tp* p) { asm volatile("" : "+s"(p)); return p; }
DI int pos32(int kk) { return 8 * ((kk >> 2) & 3) + 4 * (kk >> 4) + (kk & 3); }

constexpr int T = 32768, D = 1024, SEQ = 16384, NCHUNK = 512  , NITEM = NCHUNK * 6;
constexpr float DN_ALPHA = 1.6817928305074290f;
constexpr size_t MiB = (size_t)1 << 20;
constexpr size_t WS_WA1 = 1 * MiB, WS_WA2 = WS_WA1 + 9 * MiB, WS_WB1 = WS_WA2 + 4 * MiB, WS_WKV = WS_WB1 + 4 * MiB, WS_WMKV = WS_WKV + 1 * MiB,
                 WS_WO = WS_WMKV + 4 * MiB, WS_WUP = WS_WO + 8 * MiB, WS_WDN = WS_WUP + 8 * MiB, WS_WAB = WS_WDN + 8 * MiB, WS_ROPE = WS_WAB + 1 * MiB,
                 WS_MEMB = WS_ROPE + 8 * MiB, WS_KVMEM = WS_MEMB + 1 * MiB, WS_AB = WS_KVMEM + 2 * MiB, WS_CD = WS_AB + 2 * MiB, WS_HB = WS_CD + 1 * MiB,
                 WS_R1 = WS_HB + 64 * MiB, WS_R2 = WS_R1 + 144 * MiB, WS_END = WS_R2 + 216 * MiB;
constexpr size_t WS_UT = WS_R2, WS_REC = WS_R2 + 48 * MiB, WS_KVS = WS_R2 + 200 * MiB;
constexpr int REC_BYTES = 57344, LDS_BYTES = 147456;
namespace pg8 {
#define PG8_LAS __attribute__((address_space(3)))
typedef unsigned short bf16_t;
typedef short bf16x8 __attribute__((ext_vector_type(8)));
typedef float f32x4 __attribute__((ext_vector_type(4)));
typedef unsigned u32x4 __attribute__((ext_vector_type(4)));
constexpr int BM = 256, BK = 64, HALF = 128, HTB = HALF * BK * 2  , STAGE_BYTES = 8 * HTB, NXCD = 8, WGM = 8;

__host__ __device__ __forceinline__ int lds_byte(int r, int c) { const int st = (r >> 4) * 2 + (c >> 5), rr = r & 15, cc = c & 31, ob = rr * 64 + cc * 2; return st * 1024 + (ob ^ (((ob >> 9) & 1) << 5)); }
__host__ __device__ __forceinline__ void stage_rc(int b, int& R, int& C) { const int st = b / 1024, sb = b % 1024, swz = sb ^ (((sb >> 9) & 1) << 5); R = (st >> 1) * 16 + swz / 64; C = (st & 1) * 32 + (swz % 64) / 2; }
__host__ __device__ __forceinline__ int perm32(int rho) { const int n = rho >> 4, i = rho & 15; return 8 * (i >> 2) + 4 * n + (i & 3); }

struct Unit { int pm, pn; };
struct Gemm { const bf16_t* A; const bf16_t* Bt; int M, N, K; };

struct StaticOrder {
    int nM, nN, nwg, G, c;
    __host__ __device__ void init(int M, int N, int G_, int c_) { nM = M / BM; nN = N / BM; nwg = nM * nN; G = G_; c = c_; }
    __host__ __device__ bool next(int i, Unit& u) const {
        const long L = (long)i * G + c; if (L >= nwg) return false;
        int wgid = (int)L; { const int q = nwg / NXCD, r = nwg % NXCD, xcd = wgid % NXCD, off = wgid / NXCD; wgid = (xcd < r ? xcd * (q + 1) : r * (q + 1) + (xcd - r) * q) + off; }
        const int nig = WGM * nN, gid = wgid / nig, fm = gid * WGM, gsz = (nM - fm) < WGM ? (nM - fm) : WGM;
        u.pm = fm + ((wgid % nig) % gsz); u.pn = (wgid % nig) / gsz; return true;
    }
    __device__ __forceinline__ void a_ready(const Unit&) const {}
    __device__ __forceinline__ void done(const Unit&) const {}
};

struct EpiRes {
    static constexpr bool PERM = false, AFTER_DRAIN = false;
    const float* H; float* C; float alpha;
    __device__ __forceinline__ void operator()(const f32x4 (&acc)[2][2][4][2], const Unit& u, int wr, int wc, int fr, int fq) const {
        const int row0 = u.pm * BM + wr * 64 + fr, col0 = u.pn * BM + wc * 32 + 4 * fq;
#pragma unroll
        for (int ai = 0; ai < 2; ++ai)
#pragma unroll
            for (int m = 0; m < 4; ++m) { const size_t off = (size_t)(row0 + ai * HALF + m * 16) * 1024 + col0;
                f32x4 hv[2][2];
#pragma unroll
                for (int bj = 0; bj < 2; ++bj)
#pragma unroll
                    for (int n = 0; n < 2; ++n) hv[bj][n] = *(const f32x4*)(H + off + bj * HALF + n * 16);
#pragma unroll
                for (int bj = 0; bj < 2; ++bj)
#pragma unroll
                    for (int n = 0; n < 2; ++n) *(f32x4*)(C + off + bj * HALF + n * 16) = acc[ai][bj][m][n] + hv[bj][n] * alpha; }
    }
};
template <int ACT  > struct EpiBf16 {
    static constexpr bool PERM = true, AFTER_DRAIN = false;
    bf16_t* O; int ldc;
    __device__ __forceinline__ void operator()(const f32x4 (&acc)[2][2][4][2], const Unit& u, int wr, int wc, int fr, int fq) const {
        const int row0 = u.pm * BM + wr * 64 + fr; const int col0 = u.pn * BM + wc * 32 + 8 * fq;
#pragma unroll
        for (int ai = 0; ai < 2; ++ai)
#pragma unroll
            for (int m = 0; m < 4; ++m) { bf16_t* rowp = O + (size_t)(row0 + ai * HALF + m * 16) * ldc + col0;
#pragma unroll
                for (int bj = 0; bj < 2; ++bj) { f32x4 v0 = acc[ai][bj][m][0], v1 = acc[ai][bj][m][1];
                    if (ACT == 3) {
#pragma unroll
                        for (int j = 0; j < 4; ++j) { const float a = fmaxf(v0[j], 0.f), b = fmaxf(v1[j], 0.f); v0[j] = a * a; v1[j] = b * b; } }
                    u32x4 w; w.x = pk2(v0[0], v0[1]); w.y = pk2(v0[2], v0[3]); w.z = pk2(v1[0], v1[1]); w.w = pk2(v1[2], v1[3]);
                    *(u32x4*)(rowp + bj * HALF) = w; } }
    }
};
template <class Epi, class Sched, bool STAMP = false>
__device__ __forceinline__ void gemm_phase(PG8_LAS unsigned char* lds, const Gemm g, const Sched& S, const Epi& E, unsigned long long* stamps) {
    const int tid = opaque_tid(), wid = __builtin_amdgcn_readfirstlane(tid >> 6), lane = tid & 63, wr = wid >> 2, wc = wid & 3, fr = lane & 15, fq = lane >> 4;
    const int K = g.K, nt = K / BK;
    int ts_lo = 0, ts_hi = 0, nts = 0; const unsigned long long rt_entry = STAMP ? (unsigned long long)wall_clock64() : 0ull;
#define PG8_STAMP() do { if (STAMP && wid == 0 && nts < 64) { const unsigned long long _c = (unsigned long long)clock64(); \
        ts_lo = (lane == nts) ? (int)(unsigned)_c : ts_lo; ts_hi = (lane == nts) ? (int)(unsigned)(_c >> 32) : ts_hi; ++nts; } } while (0)
    PG8_STAMP();
    unsigned voffA[2], voffB[2];
#pragma unroll
    for (int i = 0; i < 2; ++i) { int R, C; stage_rc(tid * 16 + i * 8192, R, C); const int Rb = Epi::PERM ? ((R & ~31) + perm32(R & 31)) : R;
        voffA[i] = (unsigned)(R * K + C) * 2u; voffB[i] = (unsigned)(Rb * K + C) * 2u; }
    const size_t kstep = (size_t)(BK * 2);
    const size_t hstep = (size_t)HALF * K * 2;
    const size_t tstep = 2 * hstep;
    const unsigned ldsw = (unsigned)wid * 1024u;
    const int aoff = lds_byte(wr * 64 + fr, fq * 8), boff = lds_byte(wc * 32 + fr, fq * 8);
#define PG8_SA(b, h) (((b) * 2 + (h)) * HTB)
#define PG8_SB(b, h) ((4 + (b) * 2 + (h)) * HTB)
#define PG8_STAGE(bufoff, gbase, voff) do { _Pragma("unroll") for (int _i = 0; _i < 2; ++_i) \
        __builtin_amdgcn_global_load_lds((const unsigned*)((const char*)(gbase) + (voff)[_i]), (PG8_LAS unsigned*)(lds + (bufoff) + ldsw + _i * 8192), 16, 0, 0); } while (0)
#define PG8_LDA(dst, b, h) do { _Pragma("unroll") for (int m = 0; m < 4; ++m) _Pragma("unroll") for (int k = 0; k < 2; ++k) dst[m][k] = *(const PG8_LAS bf16x8*)(lds + PG8_SA(b, h) + aoff + m * 2048 + k * 1024); } while (0)
#define PG8_LDB(dst, b, h) do { _Pragma("unroll") for (int n = 0; n < 2; ++n) _Pragma("unroll") for (int k = 0; k < 2; ++k) dst[n][k] = *(const PG8_LAS bf16x8*)(lds + PG8_SB(b, h) + boff + n * 2048 + k * 1024); } while (0)
#define PG8_MMA(ai, bj, At, Bt) do { __builtin_amdgcn_s_setprio(1); _Pragma("unroll") for (int m = 0; m < 4; ++m) _Pragma("unroll") for (int n = 0; n < 2; ++n) _Pragma("unroll") for (int k = 0; k < 2; ++k) \
        acc[ai][bj][m][n] = __builtin_amdgcn_mfma_f32_16x16x32_bf16(Bt[n][k], At[m][k], acc[ai][bj][m][n], 0, 0, 0); __builtin_amdgcn_s_setprio(0); } while (0)
#define PG8_WAIT_V(n) asm volatile("s_waitcnt vmcnt(" #n ")" ::: "memory")
#define PG8_WAIT_L(n) asm volatile("s_waitcnt lgkmcnt(" #n ")" ::: "memory")
#define PG8_BAR __builtin_amdgcn_s_barrier()
#define PG8_SCHED __builtin_amdgcn_sched_barrier(0)
    Unit cur, nxt; int ui = 0;
    if (!S.next(0, cur)) return;
    f32x4 acc[2][2][4][2];
#pragma unroll
    for (int a = 0; a < 2; ++a)
#pragma unroll
        for (int b = 0; b < 2; ++b)
#pragma unroll
            for (int m = 0; m < 4; ++m)
#pragma unroll
                for (int n = 0; n < 2; ++n) acc[a][b][m][n] = (f32x4){0.f, 0.f, 0.f, 0.f};
    bf16x8 At[4][2], B0[2][2], B1[2][2];
    const char* cA = (const char*)g.A + (size_t)cur.pm * tstep; const char* cB = (const char*)g.Bt + (size_t)cur.pn * tstep;
    S.a_ready(cur);
    PG8_STAGE(PG8_SB(0, 0), cB, voffB); PG8_STAGE(PG8_SA(0, 0), cA, voffA); PG8_STAGE(PG8_SB(0, 1), cB + hstep, voffB); PG8_STAGE(PG8_SA(0, 1), cA + hstep, voffA);
    if (wr == 1) PG8_BAR;
    PG8_WAIT_V(4); PG8_BAR;
    PG8_STAGE(PG8_SB(1, 0), cB + kstep, voffB); PG8_STAGE(PG8_SA(1, 0), cA + kstep, voffA); PG8_STAGE(PG8_SB(1, 1), cB + hstep + kstep, voffB);
    PG8_WAIT_V(6); PG8_BAR;
    PG8_STAMP();
    for (;;) {
        const bool has_next = S.next(ui + 1, nxt);
        const char* nA = has_next ? (const char*)g.A + (size_t)nxt.pm * tstep : cA; const char* nB = has_next ? (const char*)g.Bt + (size_t)nxt.pn * tstep : cB;
        for (int t = 0; t < nt; t += 2) {
            const bool last = (t == nt - 2);
            const char* a1 = cA + (size_t)(t + 1) * kstep;
            const char* a2 = last ? nA : cA + (size_t)(t + 2) * kstep; const char* b2 = last ? nB : cB + (size_t)(t + 2) * kstep;
            const char* a3 = a2 + kstep; const char* b3 = b2 + kstep;
            if (last && has_next) S.a_ready(nxt);
            PG8_LDB(B0, 0, 0); PG8_SCHED; PG8_LDA(At, 0, 0); PG8_STAGE(PG8_SA(1, 1), a1 + hstep, voffA);
            PG8_WAIT_L(8); PG8_BAR; PG8_WAIT_L(0); PG8_MMA(0, 0, At, B0); PG8_BAR; PG8_SCHED;
            PG8_LDB(B1, 0, 1); PG8_STAGE(PG8_SB(0, 0), b2, voffB);
            PG8_BAR; PG8_WAIT_L(0); PG8_MMA(0, 1, At, B1); PG8_BAR;
            PG8_LDA(At, 0, 1); PG8_STAGE(PG8_SA(0, 0), a2, voffA);
            PG8_BAR; PG8_WAIT_L(0); PG8_MMA(1, 0, At, B0); PG8_BAR; PG8_SCHED;
            PG8_STAGE(PG8_SB(0, 1), b2 + hstep, voffB);
            PG8_WAIT_V(6); PG8_BAR; PG8_MMA(1, 1, At, B1); PG8_BAR;
            PG8_LDB(B0, 1, 0); PG8_SCHED; PG8_LDA(At, 1, 0); PG8_STAGE(PG8_SA(0, 1), a2 + hstep, voffA);
            PG8_WAIT_L(8); PG8_BAR; PG8_WAIT_L(0); PG8_MMA(0, 0, At, B0); PG8_BAR; PG8_SCHED;
            PG8_LDB(B1, 1, 1); PG8_STAGE(PG8_SB(1, 0), b3, voffB);
            PG8_BAR; PG8_WAIT_L(0); PG8_MMA(0, 1, At, B1); PG8_BAR;
            PG8_LDA(At, 1, 1); PG8_STAGE(PG8_SA(1, 0), a3, voffA);
            PG8_BAR; PG8_WAIT_L(0); PG8_MMA(1, 0, At, B0); PG8_BAR; PG8_SCHED;
            PG8_STAGE(PG8_SB(1, 1), b3 + hstep, voffB);
            PG8_WAIT_V(6); PG8_BAR; PG8_MMA(1, 1, At, B1); PG8_BAR;
        }
        PG8_STAMP();
        if constexpr (!Epi::AFTER_DRAIN) { E(acc, cur, wr, wc, fr, fq); S.done(cur); }
        PG8_STAMP();
        if (!has_next) break;
#pragma unroll
        for (int a = 0; a < 2; ++a)
#pragma unroll
            for (int b = 0; b < 2; ++b)
#pragma unroll
                for (int m = 0; m < 4; ++m)
#pragma unroll
                    for (int n = 0; n < 2; ++n) acc[a][b][m][n] = (f32x4){0.f, 0.f, 0.f, 0.f};
        cur = nxt; cA = nA; cB = nB; ++ui;
    }
    PG8_WAIT_V(0);
    if (wr == 0) PG8_BAR;
    PG8_BAR;
    if constexpr (Epi::AFTER_DRAIN) { E.fused(acc, cur, wr, wc, fr, fq, lds, wid, lane); S.done(cur); }
    PG8_STAMP();
    if (STAMP && wid == 0) { stamps[lane] = lane < nts ? (((unsigned long long)(unsigned)ts_hi << 32) | (unsigned)ts_lo) : 0ull;
        if (lane == 62) stamps[62] = rt_entry; if (lane == 63) stamps[63] = (unsigned long long)wall_clock64(); }
#undef PG8_STAMP
#undef PG8_SA
#undef PG8_SB
#undef PG8_STAGE
#undef PG8_LDA
#undef PG8_LDB
#undef PG8_MMA
#undef PG8_WAIT_V
#undef PG8_WAIT_L
#undef PG8_BAR
#undef PG8_SCHED
}
}

extern __shared__ __attribute__((aligned(16))) unsigned char smem[];
#define LDS_WAIT() asm volatile("s_waitcnt lgkmcnt(0)" ::: "memory")

DI void transpose_item(const float* __restrict__ W, int ldw, int c0, int K, int nblk, bf16_t* WT, int r0, float* scr, int item, int lane) {
    const int kb = item / nblk, nb = item % nblk, k0 = 64 * kb, n0 = 32 * nb;
#pragma unroll 8
    for (int i = 0; i < 32; ++i) { const int kk = 2 * i + (lane >> 5); scr[kk * 33 + (lane & 31)] = W[(size_t)(k0 + kk) * ldw + c0 + n0 + (lane & 31)]; }
    LDS_WAIT();
    const int c = lane & 7;
#pragma unroll
    for (int j = 0; j < 4; ++j) { const int n = (lane >> 3) + 8 * j; const float* s = scr + (8 * c) * 33 + n;
        u32x4 o; o.x = pk2(s[0 * 33], s[1 * 33]); o.y = pk2(s[2 * 33], s[3 * 33]); o.z = pk2(s[4 * 33], s[5 * 33]); o.w = pk2(s[6 * 33], s[7 * 33]);
        *(u32x4*)(WT + (size_t)(r0 + n0 + n) * K + k0 + 8 * c) = o; }
    LDS_WAIT();
}
DI bool tjob(int& r, int nitems, const float* W, int ldw, int c0, int K, int nblk, bf16_t* WT, int r0, float* scr, int lane) {
    if (r < 0) return false;
    if (r < nitems) { transpose_item(W, ldw, c0, K, nblk, WT, r0, scr, r, lane); r = -1; return true; }
    r -= nitems; return false;
}
DI void convert_mlp_weights(const float* const* in, unsigned char* ws, int layer, int gw, int ngw, int lane, float* scr) {
    const float* up = in[13] + (size_t)layer * 1024 * 4096; const float* dn = in[14] + (size_t)layer * 4096 * 1024;
    for (int it = gw; it < 4096; it += ngw) {
        if (it < 2048) transpose_item(up, 4096, 0, 1024, 128, (bf16_t*)(ws + WS_WUP), 0, scr, it, lane);
        else transpose_item(dn, 1024, 0, 4096, 32, (bf16_t*)(ws + WS_WDN), 0, scr, it - 2048, lane);
    }
}
DI void convert_small_weights(const float* const* in, unsigned char* ws, int gw, int ngw, int lane, float* scr) {
    constexpr int NIT = 2 * (1152 + 384 + 128) + 2 * 512 + 128 + 4 * 256 + 4 * 512;
    for (int it = gw; it < NIT; it += ngw) {
        int r = it;
        for (int l = 0; l < 2; ++l) {
            const float* w = in[3] + (size_t)l * 1024 * 3340;
            if (tjob(r, 1152, w, 3340, 0, 1024, 72, (bf16_t*)(ws + WS_WA1) + (size_t)l * 2304 * 1024, 0, scr, lane)) break;
            if (tjob(r, 384, w, 3340, 2304, 1024, 24, (bf16_t*)(ws + WS_WA2) + (size_t)l * 1024 * 1024, 0, scr, lane)) break;
            if (tjob(r, 128, w, 3340, 3084, 1024, 8, (bf16_t*)(ws + WS_WA2) + (size_t)l * 1024 * 1024, 768, scr, lane)) break;
        }
        for (int l = 0; l < 2; ++l) if (tjob(r, 512, in[8] + (size_t)l * 1024 * 1024, 1024, 0, 1024, 32, (bf16_t*)(ws + WS_WB1) + (size_t)l * 1024 * 1024, 0, scr, lane)) break;
        if (tjob(r, 128, in[10], 256, 0, 1024, 8, (bf16_t*)(ws + WS_WKV), 0, scr, lane)) continue;
        for (int l = 0; l < 4; ++l) if (tjob(r, 256, in[11] + (size_t)l * 1024 * 512, 512, 0, 1024, 16, (bf16_t*)(ws + WS_WMKV), l * 512, scr, lane)) break;
        for (int l = 0; l < 4; ++l) if (tjob(r, 512, in[12] + (size_t)l * 1024 * 1024, 1024, 0, 1024, 32, (bf16_t*)(ws + WS_WO) + (size_t)l * 1024 * 1024, 0, scr, lane)) break;
    }
}
template <bool DO_LN, bool WRITE_F32, bool WRITE_BF16>
DI void row_pass(const float* src, float* dstf, bf16_t* dstb, const float* g, const float* bta, const float* wab, float* ab, int gw, int ngw, int lane) {
    for (int row = gw; row < T; row += ngw) {
        const f32x4* xr = (const f32x4*)(src + (size_t)row * D) + lane;
        f32x4 v[4];
#pragma unroll
        for (int j = 0; j < 4; ++j) v[j] = xr[64 * j];
        if (DO_LN) {
            float s = 0.f;
#pragma unroll
            for (int j = 0; j < 4; ++j) s += (v[j].x + v[j].y) + (v[j].z + v[j].w);
            const float mean = wave_sum(s) * (1.f / D); float s2 = 0.f;
#pragma unroll
            for (int j = 0; j < 4; ++j) { v[j] = v[j] - mean; s2 += (v[j].x * v[j].x + v[j].y * v[j].y) + (v[j].z * v[j].z + v[j].w * v[j].w); }
            const float rstd = 1.f / sqrtf(wave_sum(s2) * (1.f / D) + 1e-5f);
#pragma unroll
            for (int j = 0; j < 4; ++j) { const f32x4 gg = ((const f32x4*)g)[lane + 64 * j], bb = ((const f32x4*)bta)[lane + 64 * j]; v[j] = v[j] * rstd * gg + bb; }
        }
        if (WRITE_F32) { f32x4* o = (f32x4*)(dstf + (size_t)row * D) + lane;
#pragma unroll
            for (int j = 0; j < 4; ++j) o[64 * j] = v[j]; }
        if (WRITE_BF16) { u32x2* o = (u32x2*)(dstb + (size_t)row * D) + lane;
#pragma unroll
            for (int j = 0; j < 4; ++j) { u32x2 w; w.x = pk2(v[j].x, v[j].y); w.y = pk2(v[j].z, v[j].w); o[64 * j] = w; } }
        if (wab) {
            float mine = 0.f;
#pragma unroll
            for (int c = 0; c < 12; ++c) { float s = 0.f;
#pragma unroll
                for (int j = 0; j < 4; ++j) { const f32x4 w = ((const f32x4*)(wab + c * 1024))[lane + 64 * j]; s += (v[j].x * w.x + v[j].y * w.y) + (v[j].z * w.z + v[j].w * w.w); }
                s = wave_sum(s); mine = (lane == c) ? s : mine; }
            if (lane < 12) ab[(size_t)row * 16 + lane] = mine;
        }
    }
}

constexpr int PX0 = 0, PX1 = 33024, PQN = 66048, PKN = PQN + 17408, PVB = PKN + 17408, PLS = PVB + 17408, PSM = PLS + 16384;
DI void prep_phase(const float* const* in, unsigned char* ws, int layer) {
    const int tid = opaque_tid(), lane = tid & 63, wid = __builtin_amdgcn_readfirstlane(tid >> 6), c16 = lane & 15, q = lane >> 4;
    float* X0 = (float*)(smem + PX0); float* X1 = (float*)(smem + PX1);
    bf16_t* QN = (bf16_t*)(smem + PQN); bf16_t* KN = (bf16_t*)(smem + PKN); bf16_t* VB = (bf16_t*)(smem + PVB);
    float* LS = (float*)(smem + PLS); float* SM = (float*)(smem + PSM);
    float* s_gc = SM, *s_beta = SM + 64, *s_eg = SM + 128, *s_ekd = SM + 192, *s_beg = SM + 256;
    bf16_t* RECI = (bf16_t*)smem;
    const bf16_t* QKV = (const bf16_t*)(ws + WS_R1);
    const float* AB = (const float*)(ws + WS_AB);
    const float* convw = in[4] + (size_t)layer * 4 * 2304;
    const int bid0 = opaque_s((int)blockIdx.x), gdim = opaque_s((int)gridDim.x);
    for (int item = bid0; item < NITEM; item += gdim) {
        const int h = item % 6, cidx = item / 6, t0 = cidx * 64, nloc = cidx & 255;
        if (tid < 384) {
            const int cgp = tid % 48, rb = tid / 48, ts = cgp >> 4, cc = (cgp & 15) * 8, col = ts * 768 + h * 128 + cc;
            f32x4 cw[4][2];
#pragma unroll
            for (int j = 0; j < 4; ++j) { cw[j][0] = *(const f32x4*)(convw + j * 2304 + col); cw[j][1] = *(const f32x4*)(convw + j * 2304 + col + 4); }
            u32x4 raw[11];
#pragma unroll
            for (int r = 0; r < 11; ++r) { const int rr = 8 * rb - 3 + r; raw[r] = (u32x4){0u, 0u, 0u, 0u};
                if (rr >= 0 || nloc != 0) raw[r] = *(const u32x4*)(QKV + (size_t)(t0 + rr) * 2304 + col); }
#pragma unroll
            for (int ro = 0; ro < 8; ++ro) {
                float y[8];
#pragma unroll
                for (int e = 0; e < 8; ++e) y[e] = 0.f;
#pragma unroll
                for (int j = 0; j < 4; ++j) { const u32x4 x = raw[ro + j];
                    y[0] += cw[j][0].x * bflo(x.x); y[1] += cw[j][0].y * bfhi(x.x); y[2] += cw[j][0].z * bflo(x.y); y[3] += cw[j][0].w * bfhi(x.y);
                    y[4] += cw[j][1].x * bflo(x.z); y[5] += cw[j][1].y * bfhi(x.z); y[6] += cw[j][1].z * bflo(x.w); y[7] += cw[j][1].w * bfhi(x.w); }
#pragma unroll
                for (int e = 0; e < 8; ++e) y[e] = y[e] / (1.f + __expf(-y[e]));
                const int row = 8 * rb + ro;
                if (ts == 2) { u32x4 o; o.x = pk2(y[0], y[1]); o.y = pk2(y[2], y[3]); o.z = pk2(y[4], y[5]); o.w = pk2(y[6], y[7]); *(u32x4*)(VB + row * 136 + cc) = o; }
                else { float* X = (ts == 0 ? X0 : X1) + row * 129 + cc;
#pragma unroll
                    for (int e = 0; e < 8; ++e) X[e] = y[e]; }
            }
        }
        __syncthreads();
        {
            const int i = tid >> 3, seg = tid & 7;
            float xq[16], xk[16], sq = 0.f, sk = 0.f;
#pragma unroll
            for (int e = 0; e < 16; ++e) { xq[e] = X0[i * 129 + 16 * seg + e]; xk[e] = X1[i * 129 + 16 * seg + e]; sq += xq[e] * xq[e]; sk += xk[e] * xk[e]; }
            sq += __shfl_xor(sq, 1); sq += __shfl_xor(sq, 2); sq += __shfl_xor(sq, 4);
            sk += __shfl_xor(sk, 1); sk += __shfl_xor(sk, 2); sk += __shfl_xor(sk, 4);
            const float rq = (1.f / sqrtf(sq + 1e-6f)) * 0.08838834764831845f, rk = 1.f / sqrtf(sk + 1e-6f);
            u32x4 o0, o1;
            o0.x = pk2(xq[0] * rq, xq[1] * rq); o0.y = pk2(xq[2] * rq, xq[3] * rq); o0.z = pk2(xq[4] * rq, xq[5] * rq); o0.w = pk2(xq[6] * rq, xq[7] * rq);
            o1.x = pk2(xq[8] * rq, xq[9] * rq); o1.y = pk2(xq[10] * rq, xq[11] * rq); o1.z = pk2(xq[12] * rq, xq[13] * rq); o1.w = pk2(xq[14] * rq, xq[15] * rq);
            *(u32x4*)(QN + i * 136 + 16 * seg) = o0; *(u32x4*)(QN + i * 136 + 16 * seg + 8) = o1;
            o0.x = pk2(xk[0] * rk, xk[1] * rk); o0.y = pk2(xk[2] * rk, xk[3] * rk); o0.z = pk2(xk[4] * rk, xk[5] * rk); o0.w = pk2(xk[6] * rk, xk[7] * rk);
            o1.x = pk2(xk[8] * rk, xk[9] * rk); o1.y = pk2(xk[10] * rk, xk[11] * rk); o1.z = pk2(xk[12] * rk, xk[13] * rk); o1.w = pk2(xk[14] * rk, xk[15] * rk);
            *(u32x4*)(KN + i * 136 + 16 * seg) = o0; *(u32x4*)(KN + i * 136 + 16 * seg + 8) = o1;
            if (wid == 0) {
                const float a = AB[(size_t)(t0 + lane) * 16 + h], bb = AB[(size_t)(t0 + lane) * 16 + 6 + h];
                const float xx = a + in[6][layer * 6 + h];
                const float sp = fmaxf(xx, 0.f) + log1pf(expf(-fabsf(xx)));
                float gc = -expf(in[5][layer * 6 + h]) * sp;
                const float beta = 1.f / (1.f + expf(-bb));
#pragma unroll
                for (int o = 1; o < 64; o <<= 1) { const float t = __shfl_up(gc, o); if (lane >= o) gc += t; }
                const float gl = __shfl(gc, 63);
                const float eg = expf(gc);
                s_gc[lane] = gc; s_beta[lane] = beta; s_eg[lane] = eg; s_ekd[lane] = expf(gl - gc); s_beg[lane] = beta * eg;
                if (lane == 63) ((float*)(ws + WS_CD))[item] = eg;
            }
        }
        __syncthreads();
        {
            const int which = wid >> 2, rt = wid & 3;
            const bf16_t* Asrc = which ? QN : KN;
            bf16x8 af[4];
#pragma unroll
            for (int s = 0; s < 4; ++s) af[s] = *(const bf16x8*)(Asrc + (16 * rt + c16) * 136 + 32 * s + 8 * q);
            float gi[4], bi[4];
#pragma unroll
            for (int r = 0; r < 4; ++r) { gi[r] = s_gc[16 * rt + 4 * q + r]; bi[r] = s_beta[16 * rt + 4 * q + r]; }
#pragma unroll
            for (int ct = 0; ct < 4; ++ct) {
                f32x4 acc = {0.f, 0.f, 0.f, 0.f};
#pragma unroll
                for (int s = 0; s < 4; ++s) { const bf16x8 bfr = *(const bf16x8*)(KN + (16 * ct + c16) * 136 + 32 * s + 8 * q); acc = MFMA16(af[s], bfr, acc); }
                const int j = 16 * ct + c16; const float gj = s_gc[j];
#pragma unroll
                for (int r = 0; r < 4; ++r) { const int i = 16 * rt + 4 * q + r;
                    const float dec = expf(fminf(gi[r] - gj, 0.f));
                    if (which == 0) LS[i * 64 + j] = (j < i) ? acc[r] * dec * bi[r] : 0.f;
                    else RECI[24576 + i * 64 + 32 * (j >> 5) + pos32(j & 31)] = f2bf((j <= i) ? acc[r] * dec : 0.f); }
            }
        }
        __syncthreads();
        if (tid < 256) {
            const int c = tid;
            int lsoff = PLS; asm volatile("" : "+v"(lsoff));
            const float* LS = (const float*)(smem + lsoff);
            const bf16_t* src = (c < 128) ? (VB + c) : (KN + (c - 128));
            const float* scl = (c < 128) ? s_beta : s_beg;
            float x[64];
#pragma unroll
            for (int i = 0; i < 64; ++i) x[i] = 0.f;
#pragma unroll
            for (int i = 0; i < 64; ++i) {
                float a0 = bf2f(src[i * 136]) * scl[i], a1 = 0.f, a2 = 0.f, a3 = 0.f;
#pragma unroll
                for (int j4 = 0; j4 < (i + 3) / 4; ++j4) { const f32x4 lv = *(const f32x4*)(LS + i * 64 + 4 * j4);
                    a0 -= lv.x * x[4 * j4]; a1 -= lv.y * x[4 * j4 + 1]; a2 -= lv.z * x[4 * j4 + 2]; a3 -= lv.w * x[4 * j4 + 3]; }
                x[i] = (a0 + a1) + (a2 + a3);
            }
            if (c < 128) { u32x4* o = (u32x4*)(ws + WS_UT + (size_t)item * 16384 + (size_t)c * 128);
#pragma unroll
                for (int e = 0; e < 8; ++e) { u32x4 w; w.x = pk2(x[8 * e], x[8 * e + 1]); w.y = pk2(x[8 * e + 2], x[8 * e + 3]); w.z = pk2(x[8 * e + 4], x[8 * e + 5]); w.w = pk2(x[8 * e + 6], x[8 * e + 7]); o[e] = w; } }
            else { const int kc = c - 128, pc = 32 * (kc >> 5) + pos32(kc & 31);
#pragma unroll
                for (int i = 0; i < 64; ++i) RECI[i * 128 + pc] = f2bf(-x[i]); }
        } else {
            const int u = tid - 256;
            { const int i = u >> 2, g = u & 3; const float eg = s_eg[i];
                float v[32];
#pragma unroll
                for (int e = 0; e < 4; ++e) { const u32x4 w = *(const u32x4*)(QN + i * 136 + 32 * g + 8 * e);
                    v[8 * e] = bflo(w.x) * eg; v[8 * e + 1] = bfhi(w.x) * eg; v[8 * e + 2] = bflo(w.y) * eg; v[8 * e + 3] = bfhi(w.y) * eg;
                    v[8 * e + 4] = bflo(w.z) * eg; v[8 * e + 5] = bfhi(w.z) * eg; v[8 * e + 6] = bflo(w.w) * eg; v[8 * e + 7] = bfhi(w.w) * eg; }
#pragma unroll
                for (int qq = 0; qq < 4; ++qq) { u32x4 w; w.x = pk2(v[4 * qq], v[4 * qq + 1]); w.y = pk2(v[4 * qq + 2], v[4 * qq + 3]); w.z = pk2(v[16 + 4 * qq], v[16 + 4 * qq + 1]); w.w = pk2(v[16 + 4 * qq + 2], v[16 + 4 * qq + 3]);
                    *(u32x4*)(RECI + 8192 + i * 128 + 32 * g + 8 * qq) = w; } }
            { const int k = u >> 1, g2 = u & 1;
                float v[32];
#pragma unroll
                for (int jj = 0; jj < 32; ++jj) v[jj] = bf2f(KN[(32 * g2 + jj) * 136 + k]) * s_ekd[32 * g2 + jj];
#pragma unroll
                for (int qq = 0; qq < 4; ++qq) { u32x4 w; w.x = pk2(v[4 * qq], v[4 * qq + 1]); w.y = pk2(v[4 * qq + 2], v[4 * qq + 3]); w.z = pk2(v[16 + 4 * qq], v[16 + 4 * qq + 1]); w.w = pk2(v[16 + 4 * qq + 2], v[16 + 4 * qq + 3]);
                    *(u32x4*)(RECI + 16384 + k * 64 + 32 * g2 + 8 * qq) = w; } }
        }
        __syncthreads();
        { const u32x4* s = (const u32x4*)smem; u32x4* d = (u32x4*)(ws + WS_REC + (size_t)item * REC_BYTES);
#pragma unroll
            for (int e = 0; e < 7; ++e) d[tid + 512 * e] = s[tid + 512 * e]; }
        __syncthreads();
    }
}

constexpr int SC_W = 0, SC_QD = 17408, SC_KDT = 34816, SC_IN = 53248, SC_OUT = 62464;
DI void scan_phase(const float* const* in, unsigned char* ws, int layer, int bh) {
    const int tid = opaque_tid(), lane = tid & 63, wid = __builtin_amdgcn_readfirstlane(tid >> 6), c16 = lane & 15, q = lane >> 4;
    bh = opaque_s(bh); const int b = bh / 6, h = bh % 6;
    const float* CD = (const float*)(ws + WS_CD);
    const bf16_t* ZQ = (const bf16_t*)(ws + WS_R1);
    bf16_t* MIX = (bf16_t*)(ws + WS_HB);
    const float* normw = in[7] + layer * 128;
    int ldsoff[7];
#pragma unroll
    for (int e = 0; e < 7; ++e) { const int o = 16 * (tid + 512 * e);
        ldsoff[e] = o < 16384 ? SC_W + (o >> 8) * 272 + (o & 255) : o < 32768 ? SC_QD + ((o - 16384) >> 8) * 272 + (o & 255)
                  : o < 49152 ? SC_KDT + ((o - 32768) >> 7) * 144 + (o & 127) : SC_IN + ((o - 49152) >> 7) * 144 + (o & 127); }
    f32x4 S[8]; bf16x8 Sb[4];
#pragma unroll
    for (int m = 0; m < 8; ++m) S[m] = (f32x4){0.f, 0.f, 0.f, 0.f};
#pragma unroll
    for (int g = 0; g < 4; ++g) Sb[g] = (bf16x8){0, 0, 0, 0, 0, 0, 0, 0};
    const int oi = tid >> 3, oseg = tid & 7;
    float nw[16];
#pragma unroll
    for (int e = 0; e < 16; ++e) nw[e] = normw[16 * oseg + e];
    const size_t item0 = (size_t)(b * 256) * 6 + h;
    { const u32x4* src = (const u32x4*)(ws + WS_REC + item0 * REC_BYTES);
#pragma unroll
        for (int e = 0; e < 7; ++e) *(u32x4*)(smem + ldsoff[e]) = src[tid + 512 * e]; }
    u32x2 ucur[4];
    { const unsigned char* ut = ws + WS_UT + item0 * 16384 + (size_t)(16 * wid + c16) * 128 + 8 * q;
#pragma unroll
        for (int m = 0; m < 4; ++m) ucur[m] = *(const u32x2*)(ut + 32 * m); }
    float cdcur = CD[item0];
    __syncthreads();
    for (int n = 0; n < 256; ++n) {
        const int nn = n < 255 ? n + 1 : 255;
        const size_t itn = (size_t)(b * 256 + nn) * 6 + h;
        const int trow = b * SEQ + n * 64;
        u32x4 pre[7];
        { const u32x4* src = (const u32x4*)(ws + WS_REC + itn * REC_BYTES);
#pragma unroll
            for (int e = 0; e < 7; ++e) pre[e] = src[tid + 512 * e]; }
        u32x2 unext[4];
        { const unsigned char* ut = ws + WS_UT + itn * 16384 + (size_t)(16 * wid + c16) * 128 + 8 * q;
#pragma unroll
            for (int m = 0; m < 4; ++m) unext[m] = *(const u32x2*)(ut + 32 * m); }
        const float cdnext = CD[itn];
        const u32x4 z0 = *(const u32x4*)(ZQ + (size_t)(trow + oi) * 1024 + h * 128 + 16 * oseg), z1 = *(const u32x4*)(ZQ + (size_t)(trow + oi) * 1024 + h * 128 + 16 * oseg + 8);
        f32x4 vn[4], oc[4];
#pragma unroll
        for (int m = 0; m < 4; ++m) {
            f32x4 acc = {bflo(ucur[m].x), bfhi(ucur[m].x), bflo(ucur[m].y), bfhi(ucur[m].y)};
            f32x4 ao = {0.f, 0.f, 0.f, 0.f};
#pragma unroll
            for (int g = 0; g < 4; ++g) {
                const bf16x8 aw = *(const bf16x8*)(smem + SC_W + (16 * m + c16) * 272 + (32 * g + 8 * q) * 2);
                const bf16x8 aq = *(const bf16x8*)(smem + SC_QD + (16 * m + c16) * 272 + (32 * g + 8 * q) * 2);
                acc = MFMA16(aw, Sb[g], acc); ao = MFMA16(aq, Sb[g], ao); }
            vn[m] = acc; oc[m] = ao;
        }
        bf16x8 Vb[2];
#pragma unroll
        for (int g = 0; g < 2; ++g) { u32x4 w; w.x = pk2(vn[2 * g][0], vn[2 * g][1]); w.y = pk2(vn[2 * g][2], vn[2 * g][3]); w.z = pk2(vn[2 * g + 1][0], vn[2 * g + 1][1]); w.w = pk2(vn[2 * g + 1][2], vn[2 * g + 1][3]);
            Vb[g] = __builtin_bit_cast(bf16x8, w); }
#pragma unroll
        for (int m = 0; m < 4; ++m) {
#pragma unroll
            for (int g = 0; g < 2; ++g) { const bf16x8 ai = *(const bf16x8*)(smem + SC_IN + (16 * m + c16) * 144 + (32 * g + 8 * q) * 2); oc[m] = MFMA16(ai, Vb[g], oc[m]); }
#pragma unroll
            for (int r = 0; r < 4; ++r) *(bf16_t*)(smem + SC_OUT + (16 * m + 4 * q + r) * 272 + (16 * wid + c16) * 2) = f2bf(oc[m][r]);
        }
#pragma unroll
        for (int m = 0; m < 8; ++m) {
            f32x4 acc = S[m] * cdcur;
#pragma unroll
            for (int g = 0; g < 2; ++g) { const bf16x8 ak = *(const bf16x8*)(smem + SC_KDT + (16 * m + c16) * 144 + (32 * g + 8 * q) * 2); acc = MFMA16(ak, Vb[g], acc); }
            S[m] = acc;
        }
#pragma unroll
        for (int g = 0; g < 4; ++g) { u32x4 w; w.x = pk2(S[2 * g][0], S[2 * g][1]); w.y = pk2(S[2 * g][2], S[2 * g][3]); w.z = pk2(S[2 * g + 1][0], S[2 * g + 1][1]); w.w = pk2(S[2 * g + 1][2], S[2 * g + 1][3]);
            Sb[g] = __builtin_bit_cast(bf16x8, w); }
        __syncthreads();
        {
            const u32x4 a0 = *(const u32x4*)(smem + SC_OUT + oi * 272 + 32 * oseg), a1 = *(const u32x4*)(smem + SC_OUT + oi * 272 + 32 * oseg + 16);
            float o[16], zz[16];
            o[0] = bflo(a0.x); o[1] = bfhi(a0.x); o[2] = bflo(a0.y); o[3] = bfhi(a0.y); o[4] = bflo(a0.z); o[5] = bfhi(a0.z); o[6] = bflo(a0.w); o[7] = bfhi(a0.w);
            o[8] = bflo(a1.x); o[9] = bfhi(a1.x); o[10] = bflo(a1.y); o[11] = bfhi(a1.y); o[12] = bflo(a1.z); o[13] = bfhi(a1.z); o[14] = bflo(a1.w); o[15] = bfhi(a1.w);
            zz[0] = bflo(z0.x); zz[1] = bfhi(z0.x); zz[2] = bflo(z0.y); zz[3] = bfhi(z0.y); zz[4] = bflo(z0.z); zz[5] = bfhi(z0.z); zz[6] = bflo(z0.w); zz[7] = bfhi(z0.w);
            zz[8] = bflo(z1.x); zz[9] = bfhi(z1.x); zz[10] = bflo(z1.y); zz[11] = bfhi(z1.y); zz[12] = bflo(z1.z); zz[13] = bfhi(z1.z); zz[14] = bflo(z1.w); zz[15] = bfhi(z1.w);
            float ss = 0.f;
#pragma unroll
            for (int e = 0; e < 16; ++e) ss += o[e] * o[e];
            ss += __shfl_xor(ss, 1); ss += __shfl_xor(ss, 2); ss += __shfl_xor(ss, 4);
            const float rr = 1.f / sqrtf(ss * (1.f / 128.f) + 1e-6f);
#pragma unroll
            for (int e = 0; e < 16; ++e) o[e] = o[e] * rr * nw[e] * (zz[e] / (1.f + __expf(-zz[e])));
            u32x4 w0, w1;
            w0.x = pk2(o[0], o[1]); w0.y = pk2(o[2], o[3]); w0.z = pk2(o[4], o[5]); w0.w = pk2(o[6], o[7]);
            w1.x = pk2(o[8], o[9]); w1.y = pk2(o[10], o[11]); w1.z = pk2(o[12], o[13]); w1.w = pk2(o[14], o[15]);
            bf16_t* dst = MIX + (size_t)(trow + oi) * 1024 + h * 128 + 16 * oseg;
            *(u32x4*)dst = w0; *(u32x4*)(dst + 8) = w1;
        }
#pragma unroll
        for (int e = 0; e < 7; ++e) *(u32x4*)(smem + ldsoff[e]) = pre[e];
#pragma unroll
        for (int m = 0; m < 4; ++m) ucur[m] = unext[m];
        cdcur = cdnext;
        __syncthreads();
    }
}

constexpr int AT_K = 0, AT_V = 36864;
template <bool MASK>
DI void attn16(bf16x8 qb0, bf16x8 qb1, float sink, int qi, bool first_block, f32x4 (&o)[4], int c16, int q) {
    f32x4 sc[16];
#pragma unroll
    for (int kt = 0; kt < 16; ++kt) {
        f32x4 acc = {0.f, 0.f, 0.f, 0.f};
        const bf16x8 k0 = *(const bf16x8*)(smem + AT_K + (16 * kt + c16) * 144 + (8 * q) * 2), k1 = *(const bf16x8*)(smem + AT_K + (16 * kt + c16) * 144 + (32 + 8 * q) * 2);
        acc = MFMA16(k0, qb0, acc); acc = MFMA16(k1, qb1, acc);
        if (MASK) {
#pragma unroll
            for (int r = 0; r < 4; ++r) { const int kj = 16 * kt + 4 * q + r, diff = qi + 128 - kj;
                const bool valid = (diff >= 0) && (diff < 128) && (!first_block || kj >= 128);
                acc[r] = valid ? acc[r] : -1e30f; }
        }
        sc[kt] = acc;
        __builtin_amdgcn_sched_barrier(0);
    }
    float m = sink;
#pragma unroll
    for (int kt = 0; kt < 16; ++kt) m = fmaxf(m, fmaxf(fmaxf(sc[kt][0], sc[kt][1]), fmaxf(sc[kt][2], sc[kt][3])));
    m = fmaxf(m, __shfl_xor(m, 16)); m = fmaxf(m, __shfl_xor(m, 32));
    float sum = 0.f;
#pragma unroll
    for (int kt = 0; kt < 16; ++kt) {
#pragma unroll
        for (int r = 0; r < 4; ++r) { const float pv = __expf(sc[kt][r] - m); sc[kt][r] = pv; sum += pv; } }
    sum += __shfl_xor(sum, 16); sum += __shfl_xor(sum, 32);
    const float inv = 1.f / (sum + __expf(sink - m));
#pragma unroll
    for (int dt = 0; dt < 4; ++dt) o[dt] = (f32x4){0.f, 0.f, 0.f, 0.f};
#pragma unroll
    for (int g = 0; g < 8; ++g) {
        u32x4 w; w.x = pk2(sc[2 * g][0], sc[2 * g][1]); w.y = pk2(sc[2 * g][2], sc[2 * g][3]); w.z = pk2(sc[2 * g + 1][0], sc[2 * g + 1][1]); w.w = pk2(sc[2 * g + 1][2], sc[2 * g + 1][3]);
        const bf16x8 pb = __builtin_bit_cast(bf16x8, w);
#pragma unroll
        for (int dt = 0; dt < 4; ++dt) { const bf16x8 va = *(const bf16x8*)(smem + AT_V + (16 * dt + c16) * 528 + (32 * g + 8 * q) * 2); o[dt] = MFMA16(va, pb, o[dt]); }
        __builtin_amdgcn_sched_barrier(0);
    }
#pragma unroll
    for (int dt = 0; dt < 4; ++dt) o[dt] = o[dt] * inv;
}
DI void store_o(bf16_t* dst, const f32x4 (&o)[4], int q) {
#pragma unroll
    for (int dt = 0; dt < 4; ++dt) { u32x2 w; w.x = pk2(o[dt][0], o[dt][1]); w.y = pk2(o[dt][2], o[dt][3]); *(u32x2*)(dst + 16 * dt + 4 * q) = w; }
}
DI void memattn_phase(unsigned char* ws, int layer, int first, int stride) {
    first = opaque_s(first); stride = opaque_s(stride);
    const int tid = opaque_tid(), lane = tid & 63, wid = __builtin_amdgcn_readfirstlane(tid >> 6), c16 = lane & 15, q = lane >> 4;
    const bf16_t* KVM = (const bf16_t*)(ws + WS_KVMEM);
    const bf16_t* QP = (const bf16_t*)(ws + WS_R1);
    bf16_t* MIX = (bf16_t*)(ws + WS_HB);
    for (int item = first; item < 256; item += stride) {
        const int b = item >> 7, h = (item >> 5) & 3, rng = item & 31;
#pragma unroll
        for (int e = 0; e < 4; ++e) { const int ch = tid + 512 * e, mk = ch >> 3, c8 = ch & 7;
            const bf16_t* rowp = KVM + (size_t)(b * 256 + mk) * 2048 + layer * 512 + h * 64 + 8 * c8;
            *(u32x4*)(smem + AT_K + mk * 144 + 16 * c8) = *(const u32x4*)rowp;
            const u32x4 v = *(const u32x4*)(rowp + 256);
            const int pk = 32 * (mk >> 5) + pos32(mk & 31);
            bf16_t* vt = (bf16_t*)(smem + AT_V) + (8 * c8) * 264 + pk;
            vt[0] = (bf16_t)(v.x & 0xffffu); vt[264] = (bf16_t)(v.x >> 16); vt[2 * 264] = (bf16_t)(v.y & 0xffffu); vt[3 * 264] = (bf16_t)(v.y >> 16);
            vt[4 * 264] = (bf16_t)(v.z & 0xffffu); vt[5 * 264] = (bf16_t)(v.z >> 16); vt[6 * 264] = (bf16_t)(v.w & 0xffffu); vt[7 * 264] = (bf16_t)(v.w >> 16); }
        __syncthreads();
        for (int tile = wid; tile < 32; tile += 8) {
            const int tok = b * SEQ + rng * 512 + tile * 16 + c16;
            const bf16_t* qp = QP + (size_t)tok * 1024 + 768 + h * 64 + 8 * q;
            const u32x4 r0 = *(const u32x4*)qp, r1 = *(const u32x4*)(qp + 32);
            u32x4 s0, s1;
            s0.x = pk2(bflo(r0.x) * 0.125f, bfhi(r0.x) * 0.125f); s0.y = pk2(bflo(r0.y) * 0.125f, bfhi(r0.y) * 0.125f); s0.z = pk2(bflo(r0.z) * 0.125f, bfhi(r0.z) * 0.125f); s0.w = pk2(bflo(r0.w) * 0.125f, bfhi(r0.w) * 0.125f);
            s1.x = pk2(bflo(r1.x) * 0.125f, bfhi(r1.x) * 0.125f); s1.y = pk2(bflo(r1.y) * 0.125f, bfhi(r1.y) * 0.125f); s1.z = pk2(bflo(r1.z) * 0.125f, bfhi(r1.z) * 0.125f); s1.w = pk2(bflo(r1.w) * 0.125f, bfhi(r1.w) * 0.125f);
            f32x4 o[4];
            attn16<false>(__builtin_bit_cast(bf16x8, s0), __builtin_bit_cast(bf16x8, s1), -1e30f, 0, false, o, c16, q);
            store_o(MIX + (size_t)tok * 1024 + 768 + h * 64, o, q);
        }
        __syncthreads();
    }
}
DI void swa_phase(const float* const* in, unsigned char* ws, int jb) {
    const int tid = opaque_tid(), lane = tid & 63, wid = __builtin_amdgcn_readfirstlane(tid >> 6), c16 = lane & 15, q = lane >> 4;
    const bf16_t* KVS = (const bf16_t*)(ws + WS_KVS);
    const bf16_t* QP = (const bf16_t*)(ws + WS_R1);
    const float* ROPE = (const float*)(ws + WS_ROPE);
    bf16_t* MIX = (bf16_t*)(ws + WS_HB);
    const float* sinks = in[9] + jb * 12;
    const int bid0 = opaque_s((int)blockIdx.x), gdim = opaque_s((int)gridDim.x);
    for (int item = bid0; item < 512; item += gdim) {
        const int b = item >> 8, kvh = (item >> 7) & 1, blk = item & 127, t0 = b * SEQ + blk * 128;
#pragma unroll
        for (int e = 0; e < 2; ++e) { const int task = tid + 512 * e, kj = task >> 2, c = task & 3; const int t = t0 - 128 + kj;
            u32x4 o1 = {0u, 0u, 0u, 0u}, o2 = {0u, 0u, 0u, 0u};
            if (blk > 0 || kj >= 128) {
                const bf16_t* kp = KVS + (size_t)t * 256 + kvh * 64 + 8 * c;
                const u32x4 a = *(const u32x4*)kp, bq = *(const u32x4*)(kp + 32);
                const float* rp = ROPE + (size_t)t * 64 + 8 * c;
                const f32x4 c0 = *(const f32x4*)rp, c1 = *(const f32x4*)(rp + 4), s0 = *(const f32x4*)(rp + 32), s1 = *(const f32x4*)(rp + 36);
                float x1[8] = {bflo(a.x), bfhi(a.x), bflo(a.y), bfhi(a.y), bflo(a.z), bfhi(a.z), bflo(a.w), bfhi(a.w)};
                float x2[8] = {bflo(bq.x), bfhi(bq.x), bflo(bq.y), bfhi(bq.y), bflo(bq.z), bfhi(bq.z), bflo(bq.w), bfhi(bq.w)};
                float cs[8] = {c0.x, c0.y, c0.z, c0.w, c1.x, c1.y, c1.z, c1.w}, sn[8] = {s0.x, s0.y, s0.z, s0.w, s1.x, s1.y, s1.z, s1.w};
                float y1[8], y2[8];
#pragma unroll
                for (int i = 0; i < 8; ++i) { y1[i] = x1[i] * cs[i] - x2[i] * sn[i]; y2[i] = x2[i] * cs[i] + x1[i] * sn[i]; }
                o1.x = pk2(y1[0], y1[1]); o1.y = pk2(y1[2], y1[3]); o1.z = pk2(y1[4], y1[5]); o1.w = pk2(y1[6], y1[7]);
                o2.x = pk2(y2[0], y2[1]); o2.y = pk2(y2[2], y2[3]); o2.z = pk2(y2[4], y2[5]); o2.w = pk2(y2[6], y2[7]);
            }
            *(u32x4*)(smem + AT_K + kj * 144 + 16 * c) = o1; *(u32x4*)(smem + AT_K + kj * 144 + 64 + 16 * c) = o2; }
#pragma unroll
        for (int e = 0; e < 4; ++e) { const int ch = tid + 512 * e, kj = ch >> 3, c8 = ch & 7; const int t = t0 - 128 + kj;
            u32x4 v = {0u, 0u, 0u, 0u};
            if (blk > 0 || kj >= 128) v = *(const u32x4*)(KVS + (size_t)t * 256 + 128 + kvh * 64 + 8 * c8);
            const int pk = 32 * (kj >> 5) + pos32(kj & 31);
            bf16_t* vt = (bf16_t*)(smem + AT_V) + (8 * c8) * 264 + pk;
            vt[0] = (bf16_t)(v.x & 0xffffu); vt[264] = (bf16_t)(v.x >> 16); vt[2 * 264] = (bf16_t)(v.y & 0xffffu); vt[3 * 264] = (bf16_t)(v.y >> 16);
            vt[4 * 264] = (bf16_t)(v.z & 0xffffu); vt[5 * 264] = (bf16_t)(v.z >> 16); vt[6 * 264] = (bf16_t)(v.w & 0xffffu); vt[7 * 264] = (bf16_t)(v.w >> 16); }
        __syncthreads();
        for (int task = wid; task < 48; task += 8) {
            const int hh = task >> 3, qt = task & 7, head = kvh * 6 + hh;
            const int tok = t0 + 16 * qt + c16;
            const bf16_t* qp = QP + (size_t)tok * 1024 + head * 64 + 8 * q;
            const u32x4 a = *(const u32x4*)qp, bq = *(const u32x4*)(qp + 32);
            const float* rp = ROPE + (size_t)tok * 64 + 8 * q;
            const f32x4 c0 = *(const f32x4*)rp, c1 = *(const f32x4*)(rp + 4), s0 = *(const f32x4*)(rp + 32), s1 = *(const f32x4*)(rp + 36);
            float x1[8] = {bflo(a.x), bfhi(a.x), bflo(a.y), bfhi(a.y), bflo(a.z), bfhi(a.z), bflo(a.w), bfhi(a.w)};
            float x2[8] = {bflo(bq.x), bfhi(bq.x), bflo(bq.y), bfhi(bq.y), bflo(bq.z), bfhi(bq.z), bflo(bq.w), bfhi(bq.w)};
            float cs[8] = {c0.x, c0.y, c0.z, c0.w, c1.x, c1.y, c1.z, c1.w}, sn[8] = {s0.x, s0.y, s0.z, s0.w, s1.x, s1.y, s1.z, s1.w};
            float y1[8], y2[8];
#pragma unroll
            for (int i = 0; i < 8; ++i) { y1[i] = (x1[i] * cs[i] - x2[i] * sn[i]) * 0.125f; y2[i] = (x2[i] * cs[i] + x1[i] * sn[i]) * 0.125f; }
            u32x4 o1, o2;
            o1.x = pk2(y1[0], y1[1]); o1.y = pk2(y1[2], y1[3]); o1.z = pk2(y1[4], y1[5]); o1.w = pk2(y1[6], y1[7]);
            o2.x = pk2(y2[0], y2[1]); o2.y = pk2(y2[2], y2[3]); o2.z = pk2(y2[4], y2[5]); o2.w = pk2(y2[6], y2[7]);
            f32x4 o[4];
            attn16<true>(__builtin_bit_cast(bf16x8, o1), __builtin_bit_cast(bf16x8, o2), sinks[head], 16 * qt + c16, blk == 0, o, c16, q);
            store_o(MIX + (size_t)tok * 1024 + head * 64, o, q);
        }
        __syncthreads();
    }
}

struct Params { const float* in[17]; float* out; unsigned char* ws; int ph_lo, ph_hi; };
template <class Epi> DI void run_gemm(const bf16_t* A, const bf16_t* Bt, int M, int N, int K, const Epi& E) {
    pg8::Gemm g{A, Bt, M, N, K}; pg8::StaticOrder S; S.init(M, N, opaque_s((int)gridDim.x), opaque_s((int)blockIdx.x));
    pg8::gemm_phase<Epi, pg8::StaticOrder, false>((PG8_LAS unsigned char*)smem, g, S, E, nullptr);
}
__global__ void __launch_bounds__(512, 2) yoco_fwd(Params p) {
    cg::grid_group grid = cg::this_grid();
    int ph = 0;
#define PHASE_BEGIN if (ph >= p.ph_lo && ph < p.ph_hi) { unsigned char* ws = opaque_ptr(p.ws); bf16_t* HB = (bf16_t*)(ws + WS_HB); const int tid = opaque_tid(), lane = tid & 63, wid = __builtin_amdgcn_readfirstlane(tid >> 6); const int gw = opaque_s((int)blockIdx.x) * 8 + wid, ngw = opaque_s((int)gridDim.x) * 8; float* scr = (float*)smem + wid * (64 * 33); (void)HB; (void)gw; (void)ngw; (void)scr; (void)lane;
#define PHASE_END   if (ph + 1 < p.ph_hi) grid.sync(); } ++ph;
    PHASE_BEGIN
        convert_small_weights(p.in, ws, gw, ngw, lane, scr);
        convert_mlp_weights(p.in, ws, 0, gw, ngw, lane, scr);
        for (int i = gw * 64 + lane; i < 2 * 12 * 1024; i += ngw * 64) { const int l = i / 12288, r = i % 12288, c = r >> 10, k = r & 1023;
            ((float*)(ws + WS_WAB))[i] = p.in[3][(size_t)l * 1024 * 3340 + (size_t)k * 3340 + 3072 + c]; }
        for (int i = gw * 64 + lane; i < T * 32; i += ngw * 64) { const int t = i >> 5, f = i & 31;
            const float invf = exp2f(-(float)f * (13.287712379549449f / 32.f));
            const float ang = (float)((const int*)p.in[2])[t] * invf;
            double rev = (double)ang * 0.15915494309189535; rev -= __builtin_rint(rev);
            const float rv = (float)rev;
            float* rp = (float*)(ws + WS_ROPE) + (size_t)t * 64 + f; rp[0] = __builtin_amdgcn_cosf(rv); rp[32] = __builtin_amdgcn_sinf(rv); }
        for (int i = gw * 64 + lane; i < 512 * 1024 / 4; i += ngw * 64) { const f32x4 v = ((const f32x4*)p.in[1])[i]; u32x2 w; w.x = pk2(v.x, v.y); w.y = pk2(v.z, v.w); ((u32x2*)(ws + WS_MEMB))[i] = w; }
    PHASE_END
    PHASE_BEGIN
        row_pass<false, false, true>(p.in[0], nullptr, HB, nullptr, nullptr, (const float*)(ws + WS_WAB), (float*)(ws + WS_AB), gw, ngw, lane);
    PHASE_END
#pragma unroll 1
    for (int layer = 0; layer < 4; ++layer) {
        const bool isA = layer < 2;
        if (isA) {
            PHASE_BEGIN
                run_gemm(HB, (const bf16_t*)(ws + WS_WA1) + (size_t)layer * 2304 * 1024, T, 2304, 1024, pg8::EpiBf16<0>{(bf16_t*)(ws + WS_R1), 2304});
                if (layer == 0) run_gemm((const bf16_t*)(ws + WS_MEMB), (const bf16_t*)(ws + WS_WMKV), 512, 2048, 1024, pg8::EpiBf16<0>{(bf16_t*)(ws + WS_KVMEM), 2048});
            PHASE_END
            PHASE_BEGIN
                prep_phase(p.in, ws, layer);
            PHASE_END
            PHASE_BEGIN
                run_gemm(HB, (const bf16_t*)(ws + WS_WA2) + (size_t)layer * 1024 * 1024, T, 1024, 1024, pg8::EpiBf16<0>{(bf16_t*)(ws + WS_R1), 1024});
            PHASE_END
            PHASE_BEGIN
                if (blockIdx.x < 12) scan_phase(p.in, ws, layer, blockIdx.x);
                else memattn_phase(ws, layer, blockIdx.x - 12, gridDim.x - 12);
            PHASE_END
        } else {
            PHASE_BEGIN
                run_gemm(HB, (const bf16_t*)(ws + WS_WB1) + (size_t)(layer - 2) * 1024 * 1024, T, 1024, 1024, pg8::EpiBf16<0>{(bf16_t*)(ws + WS_R1), 1024});
                if (layer == 2) run_gemm(HB, (const bf16_t*)(ws + WS_WKV), T, 256, 1024, pg8::EpiBf16<0>{(bf16_t*)(ws + WS_KVS), 256});
            PHASE_END
            PHASE_BEGIN
                swa_phase(p.in, ws, layer - 2);
                memattn_phase(ws, layer, blockIdx.x, gridDim.x);
            PHASE_END
        }
        PHASE_BEGIN
            run_gemm(HB, (const bf16_t*)(ws + WS_WO) + (size_t)layer * 1024 * 1024, T, 1024, 1024, pg8::EpiRes{layer == 0 ? p.in[0] : p.out, p.out, DN_ALPHA});
        PHASE_END
        PHASE_BEGIN
            row_pass<true, true, true>(p.out, p.out, HB, p.in[15] + (size_t)(layer * 2) * 1024, p.in[16] + (size_t)(layer * 2) * 1024, nullptr, nullptr, gw, ngw, lane);
        PHASE_END
        PHASE_BEGIN
            run_gemm(HB, (const bf16_t*)(ws + WS_WUP), T, 4096, 1024, pg8::EpiBf16<3>{(bf16_t*)(ws + WS_R1), 4096});
        PHASE_END
        PHASE_BEGIN
            run_gemm((const bf16_t*)(ws + WS_R1), (const bf16_t*)(ws + WS_WDN), T, 1024, 4096, pg8::EpiRes{p.out, p.out, DN_ALPHA});
        PHASE_END
        PHASE_BEGIN
            if (layer < 3) convert_mlp_weights(p.in, ws, layer + 1, gw, ngw, lane, scr);
            if (layer == 3) row_pass<true, true, false>(p.out, p.out, nullptr, p.in[15] + (size_t)(layer * 2 + 1) * 1024, p.in[16] + (size_t)(layer * 2 + 1) * 1024, nullptr, nullptr, gw, ngw, lane);
            else row_pass<true, true, true>(p.out, p.out, HB, p.in[15] + (size_t)(layer * 2 + 1) * 1024, p.in[16] + (size_t)(layer * 2 + 1) * 1024,
                                            layer == 0 ? (const float*)(ws + WS_WAB) + 12288 : nullptr, (float*)(ws + WS_AB), gw, ngw, lane);
        PHASE_END
    }
}

extern "C" void kernel_launch(void* const* d_in, const int* in_sizes, int n_in, void* d_out, int out_size, void* d_ws, size_t ws_size, hipStream_t stream) {
    static int grid = 0;
    if (grid == 0) {
        int dev = 0, cus = 0, per_cu = 0;
        hipGetDevice(&dev); hipDeviceGetAttribute(&cus, hipDeviceAttributeMultiprocessorCount, dev);
        if (hipFuncSetAttribute((const void*)yoco_fwd, hipFuncAttributeMaxDynamicSharedMemorySize, LDS_BYTES) != hipSuccess) fprintf(stderr, "kernel_launch: hipFuncSetAttribute failed\n");
        if (hipOccupancyMaxActiveBlocksPerMultiprocessor(&per_cu, (const void*)yoco_fwd, 512, LDS_BYTES) != hipSuccess || per_cu < 1) { fprintf(stderr, "kernel_launch: occupancy query says %d\n", per_cu); per_cu = 1; }
        (void)hipGetLastError();
        grid = cus * 1;
        if (ws_size < WS_END) fprintf(stderr, "kernel_launch: workspace too small: %zu < %zu\n", ws_size, (size_t)WS_END);
        if (n_in != 17) fprintf(stderr, "kernel_launch: expected 17 inputs, got %d\n", n_in);
    }
    Params p{};
    for (int i = 0; i < 17; ++i) p.in[i] = (const float*)d_in[i];
    p.out = (float*)d_out; p.ws = (unsigned char*)d_ws; p.ph_lo = 0; p.ph_hi = 1000;
    void* args[] = {&p};
    hipError_t e = hipLaunchCooperativeKernel((const void*)yoco_fwd, dim3(grid), dim3(512), args, LDS_BYTES, stream);
    if (e != hipSuccess) fprintf(stderr, "cooperative launch failed: %s (grid %d)\n", hipGetErrorString(e), grid);
}
```

```cpp
#include <hip/hip_runtime.h>
#include <hip/hip_cooperative_groups.h>
#include <cstdio>
namespace cg = cooperative_groups;
#define DI __device__ __forceinline__
typedef unsigned short bf16_t;
typedef short bf16x8 __attribute__((ext_vector_type(8)));
typedef float f32x4 __attribute__((ext_vector_type(4)));
typedef float f32x2 __attribute__((ext_vector_type(2)));
typedef unsigned u32x4 __attribute__((ext_vector_type(4)));
typedef unsigned u32x2 __attribute__((ext_vector_type(2)));
typedef __bf16 bf16x2_t __attribute__((ext_vector_type(2)));
DI unsigned pk2(float lo, float hi) { f32x2 v = {lo, hi}; bf16x2_t b = __builtin_convertvector(v, bf16x2_t); return __builtin_bit_cast(unsigned, b); }
DI float bf2f(unsigned short b) { return __uint_as_float(((unsigned)b) << 16); }
DI float bflo(unsigned w) { return __uint_as_float(w << 16); }
DI float bfhi(unsigned w) { return __uint_as_float(w & 0xffff0000u); }
DI unsigned short f2bf(float f) { return (unsigned short)(pk2(f, 0.f) & 0xffffu); }
#define MFMA16(a, b, c) __builtin_amdgcn_mfma_f32_16x16x32_bf16((a), (b), (c), 0, 0, 0)
DI float wave_sum(float v) {
#pragma unroll
    for (int o = 1; o < 64; o <<= 1) v += __shfl_xor(v, o);
    return v;
}
DI int opaque_tid() { int t = (int)threadIdx.x; asm volatile("" : "+v"(t)); return t; }
DI int opaque_s(int v) { v = __builtin_amdgcn_readfirstlane(v); asm volatile("" : "+s"(v)); return v; }
template <class Tp> DI Tp* opaque_ptr(Tp* p) { asm volatile("" : "+s"(p)); return p; }
DI int pos32(int kk) { return 8 * ((kk >> 2) & 3) + 4 * (kk >> 4) + (kk & 3); }

constexpr int T = 32768, D = 1024, SEQ = 16384, NCHUNK = 512  , NITEM = NCHUNK * 6;
constexpr float DN_ALPHA = 1.6817928305074290f;
constexpr size_t MiB = (size_t)1 << 20;
constexpr size_t WS_WA1 = 1 * MiB, WS_WA2 = WS_WA1 + 9 * MiB, WS_WB1 = WS_WA2 + 4 * MiB, WS_WKV = WS_WB1 + 4 * MiB, WS_WMKV = WS_WKV + 1 * MiB,
                 WS_WO = WS_WMKV + 4 * MiB, WS_WUP = WS_WO + 8 * MiB, WS_WDN = WS_WUP + 8 * MiB, WS_WAB = WS_WDN + 8 * MiB, WS_ROPE = WS_WAB + 1 * MiB,
                 WS_MEMB = WS_ROPE + 8 * MiB, WS_KVMEM = WS_MEMB + 1 * MiB, WS_AB = WS_KVMEM + 2 * MiB, WS_CD = WS_AB + 2 * MiB, WS_HB = WS_CD + 1 * MiB,
                 WS_R1 = WS_HB + 64 * MiB, WS_R2 = WS_R1 + 144 * MiB, WS_END = WS_R2 + 216 * MiB;
constexpr size_t WS_UT = WS_R2, WS_REC = WS_R2 + 48 * MiB, WS_KVS = WS_R2 + 200 * MiB;
constexpr int REC_BYTES = 57344, LDS_BYTES = 147456;
namespace pg8 {
#define PG8_LAS __attribute__((address_space(3)))
typedef unsigned short bf16_t;
typedef short bf16x8 __attribute__((ext_vector_type(8)));
typedef float f32x4 __attribute__((ext_vector_type(4)));
typedef unsigned u32x4 __attribute__((ext_vector_type(4)));
constexpr int BM = 256, BK = 64, HALF = 128, HTB = HALF * BK * 2  , STAGE_BYTES = 8 * HTB, NXCD = 8, WGM = 8;

__host__ __device__ __forceinline__ int lds_byte(int r, int c) { const int st = (r >> 4) * 2 + (c >> 5), rr = r & 15, cc = c & 31, ob = rr * 64 + cc * 2; return st * 1024 + (ob ^ (((ob >> 9) & 1) << 5)); }
__host__ __device__ __forceinline__ void stage_rc(int b, int& R, int& C) { const int st = b / 1024, sb = b % 1024, swz = sb ^ (((sb >> 9) & 1) << 5); R = (st >> 1) * 16 + swz / 64; C = (st & 1) * 32 + (swz % 64) / 2; }
__host__ __device__ __forceinline__ int perm32(int rho) { const int n = rho >> 4, i = rho & 15; return 8 * (i >> 2) + 4 * n + (i & 3); }

struct Unit { int pm, pn; };
struct Gemm { const bf16_t* A; const bf16_t* Bt; int M, N, K; };

struct StaticOrder {
    int nM, nN, nwg, G, c;
    __host__ __device__ void init(int M, int N, int G_, int c_) { nM = M / BM; nN = N / BM; nwg = nM * nN; G = G_; c = c_; }
    __host__ __device__ bool next(int i, Unit& u) const {
        const long L = (long)i * G + c; if (L >= nwg) return false;
        int wgid = (int)L; { const int q = nwg / NXCD, r = nwg % NXCD, xcd = wgid % NXCD, off = wgid / NXCD; wgid = (xcd < r ? xcd * (q + 1) : r * (q + 1) + (xcd - r) * q) + off; }
        const int nig = WGM * nN, gid = wgid / nig, fm = gid * WGM, gsz = (nM - fm) < WGM ? (nM - fm) : WGM;
        u.pm = fm + ((wgid % nig) % gsz); u.pn = (wgid % nig) / gsz; return true;
    }
    __device__ __forceinline__ void a_ready(const Unit&) const {}
    __device__ __forceinline__ void done(const Unit&) const {}
};

struct EpiRes {
    static constexpr bool PERM = false, AFTER_DRAIN = false;
    const float* H; float* C; float alpha;
    __device__ __forceinline__ void operator()(const f32x4 (&acc)[2][2][4][2], const Unit& u, int wr, int wc, int fr, int fq) const {
        const int row0 = u.pm * BM + wr * 64 + fr, col0 = u.pn * BM + wc * 32 + 4 * fq;
#pragma unroll
        for (int ai = 0; ai < 2; ++ai)
#pragma unroll
            for (int m = 0; m < 4; ++m) { const size_t off = (size_t)(row0 + ai * HALF + m * 16) * 1024 + col0;
                f32x4 hv[2][2];
#pragma unroll
                for (int bj = 0; bj < 2; ++bj)
#pragma unroll
                    for (int n = 0; n < 2; ++n) hv[bj][n] = *(const f32x4*)(H + off + bj * HALF + n * 16);
#pragma unroll
                for (int bj = 0; bj < 2; ++bj)
#pragma unroll
                    for (int n = 0; n < 2; ++n) *(f32x4*)(C + off + bj * HALF + n * 16) = acc[ai][bj][m][n] + hv[bj][n] * alpha; }
    }
};
struct EpiResB {
    static constexpr bool PERM = false, AFTER_DRAIN = false;
    const bf16_t* Hb; float* C; float alpha;
    __device__ __forceinline__ void operator()(const f32x4 (&acc)[2][2][4][2], const Unit& u, int wr, int wc, int fr, int fq) const {
        const int row0 = u.pm * BM + wr * 64 + fr, col0 = u.pn * BM + wc * 32 + 4 * fq;
#pragma unroll
        for (int ai = 0; ai < 2; ++ai)
#pragma unroll
            for (int m = 0; m < 4; ++m) { const size_t off = (size_t)(row0 + ai * HALF + m * 16) * 1024 + col0;
                u32x2 hb[2][2];
#pragma unroll
                for (int bj = 0; bj < 2; ++bj)
#pragma unroll
                    for (int n = 0; n < 2; ++n) hb[bj][n] = *(const u32x2*)(Hb + off + bj * HALF + n * 16);
#pragma unroll
                for (int bj = 0; bj < 2; ++bj)
#pragma unroll
                    for (int n = 0; n < 2; ++n) { const f32x4 hv = {bflo(hb[bj][n].x), bfhi(hb[bj][n].x), bflo(hb[bj][n].y), bfhi(hb[bj][n].y)};
                        *(f32x4*)(C + off + bj * HALF + n * 16) = acc[ai][bj][m][n] + hv * alpha; } }
    }
};
template <int ACT  > struct EpiBf16 {
    static constexpr bool PERM = true, AFTER_DRAIN = false;
    bf16_t* O; int ldc;
    __device__ __forceinline__ void operator()(const f32x4 (&acc)[2][2][4][2], const Unit& u, int wr, int wc, int fr, int fq) const {
        const int row0 = u.pm * BM + wr * 64 + fr; const int col0 = u.pn * BM + wc * 32 + 8 * fq;
#pragma unroll
        for (int ai = 0; ai < 2; ++ai)
#pragma unroll
            for (int m = 0; m < 4; ++m) { bf16_t* rowp = O + (size_t)(row0 + ai * HALF + m * 16) * ldc + col0;
#pragma unroll
                for (int bj = 0; bj < 2; ++bj) { f32x4 v0 = acc[ai][bj][m][0], v1 = acc[ai][bj][m][1];
                    if (ACT == 3) {
#pragma unroll
                        for (int j = 0; j < 4; ++j) { const float a = fmaxf(v0[j], 0.f), b = fmaxf(v1[j], 0.f); v0[j] = a * a; v1[j] = b * b; } }
                    u32x4 w; w.x = pk2(v0[0], v0[1]); w.y = pk2(v0[2], v0[3]); w.z = pk2(v1[0], v1[1]); w.w = pk2(v1[2], v1[3]);
                    *(u32x4*)(rowp + bj * HALF) = w; } }
    }
};
template <class Epi, class Sched, bool STAMP = false>
__device__ __forceinline__ void gemm_phase(PG8_LAS unsigned char* lds, const Gemm g, const Sched& S, const Epi& E, unsigned long long* stamps) {
    const int tid = opaque_tid(), wid = __builtin_amdgcn_readfirstlane(tid >> 6), lane = tid & 63, wr = wid >> 2, wc = wid & 3, fr = lane & 15, fq = lane >> 4;
    const int K = g.K, nt = K / BK;
    int ts_lo = 0, ts_hi = 0, nts = 0; const unsigned long long rt_entry = STAMP ? (unsigned long long)wall_clock64() : 0ull;
#define PG8_STAMP() do { if (STAMP && wid == 0 && nts < 64) { const unsigned long long _c = (unsigned long long)clock64(); \
        ts_lo = (lane == nts) ? (int)(unsigned)_c : ts_lo; ts_hi = (lane == nts) ? (int)(unsigned)(_c >> 32) : ts_hi; ++nts; } } while (0)
    PG8_STAMP();
    unsigned voffA[2], voffB[2];
#pragma unroll
    for (int i = 0; i < 2; ++i) { int R, C; stage_rc(tid * 16 + i * 8192, R, C); const int Rb = Epi::PERM ? ((R & ~31) + perm32(R & 31)) : R;
        voffA[i] = (unsigned)(R * K + C) * 2u; voffB[i] = (unsigned)(Rb * K + C) * 2u; }
    const size_t kstep = (size_t)(BK * 2);
    const size_t hstep = (size_t)HALF * K * 2;
    const size_t tstep = 2 * hstep;
    const unsigned ldsw = (unsigned)wid * 1024u;
    const int aoff = lds_byte(wr * 64 + fr, fq * 8), boff = lds_byte(wc * 32 + fr, fq * 8);
#define PG8_SA(b, h) (((b) * 2 + (h)) * HTB)
#define PG8_SB(b, h) ((4 + (b) * 2 + (h)) * HTB)
#define PG8_STAGE(bufoff, gbase, voff) do { _Pragma("unroll") for (int _i = 0; _i < 2; ++_i) \
        __builtin_amdgcn_global_load_lds((const unsigned*)((const char*)(gbase) + (voff)[_i]), (PG8_LAS unsigned*)(lds + (bufoff) + ldsw + _i * 8192), 16, 0, 0); } while (0)
#define PG8_LDA(dst, b, h) do { _Pragma("unroll") for (int m = 0; m < 4; ++m) _Pragma("unroll") for (int k = 0; k < 2; ++k) dst[m][k] = *(const PG8_LAS bf16x8*)(lds + PG8_SA(b, h) + aoff + m * 2048 + k * 1024); } while (0)
#define PG8_LDB(dst, b, h) do { _Pragma("unroll") for (int n = 0; n < 2; ++n) _Pragma("unroll") for (int k = 0; k < 2; ++k) dst[n][k] = *(const PG8_LAS bf16x8*)(lds + PG8_SB(b, h) + boff + n * 2048 + k * 1024); } while (0)
#define PG8_MMA(ai, bj, At, Bt) do { __builtin_amdgcn_s_setprio(1); _Pragma("unroll") for (int m = 0; m < 4; ++m) _Pragma("unroll") for (int n = 0; n < 2; ++n) _Pragma("unroll") for (int k = 0; k < 2; ++k) \
        acc[ai][bj][m][n] = __builtin_amdgcn_mfma_f32_16x16x32_bf16(Bt[n][k], At[m][k], acc[ai][bj][m][n], 0, 0, 0); __builtin_amdgcn_s_setprio(0); } while (0)
#define PG8_WAIT_V(n) asm volatile("s_waitcnt vmcnt(" #n ")" ::: "memory")
#define PG8_WAIT_L(n) asm volatile("s_waitcnt lgkmcnt(" #n ")" ::: "memory")
#define PG8_BAR __builtin_amdgcn_s_barrier()
#define PG8_SCHED __builtin_amdgcn_sched_barrier(0)
    Unit cur, nxt; int ui = 0;
    if (!S.next(0, cur)) return;
    f32x4 acc[2][2][4][2];
#pragma unroll
    for (int a = 0; a < 2; ++a)
#pragma unroll
        for (int b = 0; b < 2; ++b)
#pragma unroll
            for (int m = 0; m < 4; ++m)
#pragma unroll
                for (int n = 0; n < 2; ++n) acc[a][b][m][n] = (f32x4){0.f, 0.f, 0.f, 0.f};
    bf16x8 At[4][2], B0[2][2], B1[2][2];
    const char* cA = (const char*)g.A + (size_t)cur.pm * tstep; const char* cB = (const char*)g.Bt + (size_t)cur.pn * tstep;
    S.a_ready(cur);
    PG8_STAGE(PG8_SB(0, 0), cB, voffB); PG8_STAGE(PG8_SA(0, 0), cA, voffA); PG8_STAGE(PG8_SB(0, 1), cB + hstep, voffB); PG8_STAGE(PG8_SA(0, 1), cA + hstep, voffA);
    if (wr == 1) PG8_BAR;
    PG8_WAIT_V(4); PG8_BAR;
    PG8_STAGE(PG8_SB(1, 0), cB + kstep, voffB); PG8_STAGE(PG8_SA(1, 0), cA + kstep, voffA); PG8_STAGE(PG8_SB(1, 1), cB + hstep + kstep, voffB);
    PG8_WAIT_V(6); PG8_BAR;
    PG8_STAMP();
    for (;;) {
        const bool has_next = S.next(ui + 1, nxt);
        const char* nA = has_next ? (const char*)g.A + (size_t)nxt.pm * tstep : cA; const char* nB = has_next ? (const char*)g.Bt + (size_t)nxt.pn * tstep : cB;
        for (int t = 0; t < nt; t += 2) {
            const bool last = (t == nt - 2);
            const char* a1 = cA + (size_t)(t + 1) * kstep;
            const char* a2 = last ? nA : cA + (size_t)(t + 2) * kstep; const char* b2 = last ? nB : cB + (size_t)(t + 2) * kstep;
            const char* a3 = a2 + kstep; const char* b3 = b2 + kstep;
            if (last && has_next) S.a_ready(nxt);
            PG8_LDB(B0, 0, 0); PG8_SCHED; PG8_LDA(At, 0, 0); PG8_STAGE(PG8_SA(1, 1), a1 + hstep, voffA);
            PG8_WAIT_L(8); PG8_BAR; PG8_WAIT_L(0); PG8_MMA(0, 0, At, B0); PG8_BAR; PG8_SCHED;
            PG8_LDB(B1, 0, 1); PG8_STAGE(PG8_SB(0, 0), b2, voffB);
            PG8_BAR; PG8_WAIT_L(0); PG8_MMA(0, 1, At, B1); PG8_BAR;
            PG8_LDA(At, 0, 1); PG8_STAGE(PG8_SA(0, 0), a2, voffA);
            PG8_BAR; PG8_WAIT_L(0); PG8_MMA(1, 0, At, B0); PG8_BAR; PG8_SCHED;
            PG8_STAGE(PG8_SB(0, 1), b2 + hstep, voffB);
            PG8_WAIT_V(6); PG8_BAR; PG8_MMA(1, 1, At, B1); PG8_BAR;
            PG8_LDB(B0, 1, 0); PG8_SCHED; PG8_LDA(At, 1, 0); PG8_STAGE(PG8_SA(0, 1), a2 + hstep, voffA);
            PG8_WAIT_L(8); PG8_BAR; PG8_WAIT_L(0); PG8_MMA(0, 0, At, B0); PG8_BAR; PG8_SCHED;
            PG8_LDB(B1, 1, 1); PG8_STAGE(PG8_SB(1, 0), b3, voffB);
            PG8_BAR; PG8_WAIT_L(0); PG8_MMA(0, 1, At, B1); PG8_BAR;
            PG8_LDA(At, 1, 1); PG8_STAGE(PG8_SA(1, 0), a3, voffA);
            PG8_BAR; PG8_WAIT_L(0); PG8_MMA(1, 0, At, B0); PG8_BAR; PG8_SCHED;
            PG8_STAGE(PG8_SB(1, 1), b3 + hstep, voffB);
            PG8_WAIT_V(6); PG8_BAR; PG8_MMA(1, 1, At, B1); PG8_BAR;
        }
        PG8_STAMP();
        if constexpr (!Epi::AFTER_DRAIN) { E(acc, cur, wr, wc, fr, fq); S.done(cur); }
        PG8_STAMP();
        if (!has_next) break;
#pragma unroll
        for (int a = 0; a < 2; ++a)
#pragma unroll
            for (int b = 0; b < 2; ++b)
#pragma unroll
                for (int m = 0; m < 4; ++m)
#pragma unroll
                    for (int n = 0; n < 2; ++n) acc[a][b][m][n] = (f32x4){0.f, 0.f, 0.f, 0.f};
        cur = nxt; cA = nA; cB = nB; ++ui;
    }
    PG8_WAIT_V(0);
    if (wr == 0) PG8_BAR;
    PG8_BAR;
    if constexpr (Epi::AFTER_DRAIN) { E.fused(acc, cur, wr, wc, fr, fq, lds, wid, lane); S.done(cur); }
    PG8_STAMP();
    if (STAMP && wid == 0) { stamps[lane] = lane < nts ? (((unsigned long long)(unsigned)ts_hi << 32) | (unsigned)ts_lo) : 0ull;
        if (lane == 62) stamps[62] = rt_entry; if (lane == 63) stamps[63] = (unsigned long long)wall_clock64(); }
#undef PG8_STAMP
#undef PG8_SA
#undef PG8_SB
#undef PG8_STAGE
#undef PG8_LDA
#undef PG8_LDB
#undef PG8_MMA
#undef PG8_WAIT_V
#undef PG8_WAIT_L
#undef PG8_BAR
#undef PG8_SCHED
}
}

extern __shared__ __attribute__((aligned(16))) unsigned char smem[];
#define LDS_WAIT() asm volatile("s_waitcnt lgkmcnt(0)" ::: "memory")

DI void transpose_item(const float* __restrict__ W, int ldw, int c0, int K, int nblk, bf16_t* WT, int r0, float* scr, int item, int lane) {
    const int kb = item / nblk, nb = item % nblk, k0 = 64 * kb, n0 = 32 * nb;
    float wv[32];
#pragma unroll
    for (int i = 0; i < 32; ++i) { const int kk = 2 * i + (lane >> 5); wv[i] = __builtin_nontemporal_load(W + (size_t)(k0 + kk) * ldw + c0 + n0 + (lane & 31)); }
#pragma unroll
    for (int i = 0; i < 32; ++i) { const int kk = 2 * i + (lane >> 5); scr[kk * 33 + (lane & 31)] = wv[i]; }
    LDS_WAIT();
    const int c = lane & 7;
#pragma unroll
    for (int j = 0; j < 4; ++j) { const int n = (lane >> 3) + 8 * j; const float* s = scr + (8 * c) * 33 + n;
        u32x4 o; o.x = pk2(s[0 * 33], s[1 * 33]); o.y = pk2(s[2 * 33], s[3 * 33]); o.z = pk2(s[4 * 33], s[5 * 33]); o.w = pk2(s[6 * 33], s[7 * 33]);
        *(u32x4*)(WT + (size_t)(r0 + n0 + n) * K + k0 + 8 * c) = o; }
    LDS_WAIT();
}
DI bool tjob(int& r, int nitems, const float* W, int ldw, int c0, int K, int nblk, bf16_t* WT, int r0, float* scr, int lane) {
    if (r < 0) return false;
    if (r < nitems) { transpose_item(W, ldw, c0, K, nblk, WT, r0, scr, r, lane); r = -1; return true; }
    r -= nitems; return false;
}
DI void convert_mlp_weights(const float* const* in, unsigned char* ws, int layer, int gw, int ngw, int lane, float* scr) {
    const float* up = in[13] + (size_t)layer * 1024 * 4096; const float* dn = in[14] + (size_t)layer * 4096 * 1024;
    for (int it = gw; it < 4096; it += ngw) {
        if (it < 2048) transpose_item(up, 4096, 0, 1024, 128, (bf16_t*)(ws + WS_WUP), 0, scr, it, lane);
        else transpose_item(dn, 1024, 0, 4096, 32, (bf16_t*)(ws + WS_WDN), 0, scr, it - 2048, lane);
    }
}
DI void convert_small_weights(const float* const* in, unsigned char* ws, int part, int gw, int ngw, int lane, float* scr) {
    if (part == 0) {
        constexpr int NIT = 1152 + 384 + 128 + 4 * 256;
        for (int it = gw; it < NIT; it += ngw) {
            int r = it;
            const float* w = in[3];
            tjob(r, 1152, w, 3340, 0, 1024, 72, (bf16_t*)(ws + WS_WA1), 0, scr, lane);
            tjob(r, 384, w, 3340, 2304, 1024, 24, (bf16_t*)(ws + WS_WA2), 0, scr, lane);
            tjob(r, 128, w, 3340, 3084, 1024, 8, (bf16_t*)(ws + WS_WA2), 768, scr, lane);
            for (int l = 0; l < 4; ++l) tjob(r, 256, in[11] + (size_t)l * 1024 * 512, 512, 0, 1024, 16, (bf16_t*)(ws + WS_WMKV), l * 512, scr, lane);
        }
    } else {
        constexpr int NIT = 1152 + 384 + 128 + 2 * 512 + 128 + 4 * 512;
        for (int it = gw; it < NIT; it += ngw) {
            int r = it;
            const float* w = in[3] + (size_t)1024 * 3340;
            tjob(r, 1152, w, 3340, 0, 1024, 72, (bf16_t*)(ws + WS_WA1) + (size_t)2304 * 1024, 0, scr, lane);
            tjob(r, 384, w, 3340, 2304, 1024, 24, (bf16_t*)(ws + WS_WA2) + (size_t)1024 * 1024, 0, scr, lane);
            tjob(r, 128, w, 3340, 3084, 1024, 8, (bf16_t*)(ws + WS_WA2) + (size_t)1024 * 1024, 768, scr, lane);
            for (int l = 0; l < 2; ++l) tjob(r, 512, in[8] + (size_t)l * 1024 * 1024, 1024, 0, 1024, 32, (bf16_t*)(ws + WS_WB1) + (size_t)l * 1024 * 1024, 0, scr, lane);
            tjob(r, 128, in[10], 256, 0, 1024, 8, (bf16_t*)(ws + WS_WKV), 0, scr, lane);
            for (int l = 0; l < 4; ++l) tjob(r, 512, in[12] + (size_t)l * 1024 * 1024, 1024, 0, 1024, 32, (bf16_t*)(ws + WS_WO) + (size_t)l * 1024 * 1024, 0, scr, lane);
        }
    }
}
template <bool DO_LN, bool WRITE_F32, bool WRITE_BF16>
DI void row_pass(const float* src, float* dstf, bf16_t* dstb, const float* g, const float* bta, const float* wab, float* ab, int gw, int ngw, int lane) {
    if (wab) {
        const int tid_ = opaque_tid();
#pragma unroll
        for (int e = 0; e < 2; ++e) { const int k = tid_ + 512 * e; const f32x4* wp = (const f32x4*)(wab + (size_t)k * 3340 + 3072); const f32x4 w0 = wp[0], w1 = wp[1], w2 = wp[2];
            float* sm = (float*)smem + k; sm[0] = w0.x; sm[1024] = w0.y; sm[2048] = w0.z; sm[3072] = w0.w; sm[4096] = w1.x; sm[5120] = w1.y; sm[6144] = w1.z; sm[7168] = w1.w; sm[8192] = w2.x; sm[9216] = w2.y; sm[10240] = w2.z; sm[11264] = w2.w; }
        __syncthreads();
    }
    f32x4 vn[4];
    if (gw < T) { const f32x4* xr = (const f32x4*)(src + (size_t)gw * D) + lane;
#pragma unroll
        for (int j = 0; j < 4; ++j) vn[j] = __builtin_nontemporal_load(xr + 64 * j); }
    for (int row = gw; row < T; row += ngw) {
        f32x4 v[4];
#pragma unroll
        for (int j = 0; j < 4; ++j) v[j] = vn[j];
        if (row + ngw < T) { const f32x4* xr = (const f32x4*)(src + (size_t)(row + ngw) * D) + lane;
#pragma unroll
            for (int j = 0; j < 4; ++j) vn[j] = __builtin_nontemporal_load(xr + 64 * j); }
        __builtin_amdgcn_sched_barrier(0);
        if (DO_LN) {
            float s = 0.f;
#pragma unroll
            for (int j = 0; j < 4; ++j) s += (v[j].x + v[j].y) + (v[j].z + v[j].w);
            const float mean = wave_sum(s) * (1.f / D); float s2 = 0.f;
#pragma unroll
            for (int j = 0; j < 4; ++j) { v[j] = v[j] - mean; s2 += (v[j].x * v[j].x + v[j].y * v[j].y) + (v[j].z * v[j].z + v[j].w * v[j].w); }
            const float rstd = 1.f / sqrtf(wave_sum(s2) * (1.f / D) + 1e-5f);
#pragma unroll
            for (int j = 0; j < 4; ++j) { const f32x4 gg = ((const f32x4*)g)[lane + 64 * j], bb = ((const f32x4*)bta)[lane + 64 * j]; v[j] = v[j] * rstd * gg + bb; }
        }
        if (WRITE_F32) { f32x4* o = (f32x4*)(dstf + (size_t)row * D) + lane;
#pragma unroll
            for (int j = 0; j < 4; ++j) __builtin_nontemporal_store(v[j], o + 64 * j); }
        if (WRITE_BF16) { u32x2* o = (u32x2*)(dstb + (size_t)row * D) + lane;
#pragma unroll
            for (int j = 0; j < 4; ++j) { u32x2 w; w.x = pk2(v[j].x, v[j].y); w.y = pk2(v[j].z, v[j].w); o[64 * j] = w; } }
        if (wab) {
            float a[16];
#pragma unroll
            for (int c = 0; c < 12; ++c) { float s = 0.f;
#pragma unroll
                for (int j = 0; j < 4; ++j) { const f32x4 w = ((const f32x4*)(smem + c * 4096))[lane + 64 * j]; s += (v[j].x * w.x + v[j].y * w.y) + (v[j].z * w.z + v[j].w * w.w); }
                a[c] = s; }
            a[12] = a[13] = a[14] = a[15] = 0.f;
            const bool h5 = (lane & 32) != 0, h4 = (lane & 16) != 0, h3 = (lane & 8) != 0, h2 = (lane & 4) != 0;
            float b8[8], b4[4], b2[2];
#pragma unroll
            for (int i = 0; i < 8; ++i) { const float keep = h5 ? a[8 + i] : a[i], send = h5 ? a[i] : a[8 + i]; b8[i] = keep + __shfl_xor(send, 32); }
#pragma unroll
            for (int i = 0; i < 4; ++i) { const float keep = h4 ? b8[4 + i] : b8[i], send = h4 ? b8[i] : b8[4 + i]; b4[i] = keep + __shfl_xor(send, 16); }
#pragma unroll
            for (int i = 0; i < 2; ++i) { const float keep = h3 ? b4[2 + i] : b4[i], send = h3 ? b4[i] : b4[2 + i]; b2[i] = keep + __shfl_xor(send, 8); }
            float r1 = (h2 ? b2[1] : b2[0]) + __shfl_xor(h2 ? b2[0] : b2[1], 4);
            r1 += __shfl_xor(r1, 2); r1 += __shfl_xor(r1, 1);
            const int idx = ((lane >> 5) & 1) * 8 + ((lane >> 4) & 1) * 4 + ((lane >> 3) & 1) * 2 + ((lane >> 2) & 1);
            if ((lane & 3) == 0 && idx < 12) ab[(size_t)row * 16 + idx] = r1;
        }
    }
}
constexpr int PX0 = 0, PX1 = 33792, PQN = 67584, PKN = PQN + 17408, PVB = PKN + 17408, PLS = PVB + 17408, PSM = PLS + 16384;
DI void prep_phase(const float* const* in, unsigned char* ws, int layer) {
    const int tid = opaque_tid(), lane = tid & 63, wid = __builtin_amdgcn_readfirstlane(tid >> 6), c16 = lane & 15, q = lane >> 4;
    float* X0 = (float*)(smem + PX0); float* X1 = (float*)(smem + PX1);
    bf16_t* QN = (bf16_t*)(smem + PQN); bf16_t* KN = (bf16_t*)(smem + PKN); bf16_t* VB = (bf16_t*)(smem + PVB);
    float* LD = (float*)(smem + PLS); bf16_t* NB = (bf16_t*)(smem + PLS + 4096); bf16_t* TA = (bf16_t*)(smem + 57344); float* SM = (float*)(smem + PSM);
    float* s_gc = SM, *s_beta = SM + 64, *s_eg = SM + 128, *s_ekd = SM + 192, *s_beg = SM + 256;
    bf16_t* RECI = (bf16_t*)smem;
    const bf16_t* QKV = (const bf16_t*)(ws + WS_R1);
    const float* AB = (const float*)(ws + WS_AB);
    const float* convw = in[4] + (size_t)layer * 4 * 2304;
    const int bid0 = opaque_s((int)blockIdx.x), gdim = opaque_s((int)gridDim.x);
    for (int item = bid0; item < NITEM; item += gdim) {
        const int h = item % 6, cidx = item / 6, t0 = cidx * 64, nloc = cidx & 255;
        const int ridx = ((cidx >> 8) * 6 + h) * 256 + nloc;
        if (tid < 384) {
            const int cgp = tid % 48, rb = tid / 48, ts = cgp >> 4, cc = (cgp & 15) * 8, col = ts * 768 + h * 128 + cc;
            f32x4 cw[4][2];
#pragma unroll
            for (int j = 0; j < 4; ++j) { cw[j][0] = *(const f32x4*)(convw + j * 2304 + col); cw[j][1] = *(const f32x4*)(convw + j * 2304 + col + 4); }
            u32x4 raw[11];
#pragma unroll
            for (int r = 0; r < 11; ++r) { const int rr = 8 * rb - 3 + r; raw[r] = (u32x4){0u, 0u, 0u, 0u};
                if (rr >= 0 || nloc != 0) raw[r] = *(const u32x4*)(QKV + (size_t)(t0 + rr) * 2304 + col); }
#pragma unroll
            for (int ro = 0; ro < 8; ++ro) {
                float y[8];
#pragma unroll
                for (int e = 0; e < 8; ++e) y[e] = 0.f;
#pragma unroll
                for (int j = 0; j < 4; ++j) { const u32x4 x = raw[ro + j];
                    y[0] += cw[j][0].x * bflo(x.x); y[1] += cw[j][0].y * bfhi(x.x); y[2] += cw[j][0].z * bflo(x.y); y[3] += cw[j][0].w * bfhi(x.y);
                    y[4] += cw[j][1].x * bflo(x.z); y[5] += cw[j][1].y * bfhi(x.z); y[6] += cw[j][1].z * bflo(x.w); y[7] += cw[j][1].w * bfhi(x.w); }
#pragma unroll
                for (int e = 0; e < 8; ++e) y[e] = y[e] * __builtin_amdgcn_rcpf(1.f + __expf(-y[e]));
                const int row = 8 * rb + ro;
                if (ts == 2) { u32x4 o; o.x = pk2(y[0], y[1]); o.y = pk2(y[2], y[3]); o.z = pk2(y[4], y[5]); o.w = pk2(y[6], y[7]); *(u32x4*)(VB + row * 136 + cc) = o; }
                else { float* X = (ts == 0 ? X0 : X1) + row * 132 + cc;
                    *(f32x4*)X = (f32x4){y[0], y[1], y[2], y[3]}; *(f32x4*)(X + 4) = (f32x4){y[4], y[5], y[6], y[7]}; }
            }
        }
        __syncthreads();
        {
            const int i = tid >> 3, seg = tid & 7;
            float xq[16], xk[16], sq = 0.f, sk = 0.f;
#pragma unroll
            for (int e4 = 0; e4 < 4; ++e4) { const f32x4 a = *(const f32x4*)(X0 + i * 132 + 16 * seg + 4 * e4), b = *(const f32x4*)(X1 + i * 132 + 16 * seg + 4 * e4);
                xq[4 * e4] = a.x; xq[4 * e4 + 1] = a.y; xq[4 * e4 + 2] = a.z; xq[4 * e4 + 3] = a.w; xk[4 * e4] = b.x; xk[4 * e4 + 1] = b.y; xk[4 * e4 + 2] = b.z; xk[4 * e4 + 3] = b.w; }
#pragma unroll
            for (int e = 0; e < 16; ++e) { sq += xq[e] * xq[e]; sk += xk[e] * xk[e]; }
            sq += __shfl_xor(sq, 1); sq += __shfl_xor(sq, 2); sq += __shfl_xor(sq, 4);
            sk += __shfl_xor(sk, 1); sk += __shfl_xor(sk, 2); sk += __shfl_xor(sk, 4);
            const float rq = (1.f / sqrtf(sq + 1e-6f)) * 0.08838834764831845f, rk = 1.f / sqrtf(sk + 1e-6f);
            u32x4 o0, o1;
            o0.x = pk2(xq[0] * rq, xq[1] * rq); o0.y = pk2(xq[2] * rq, xq[3] * rq); o0.z = pk2(xq[4] * rq, xq[5] * rq); o0.w = pk2(xq[6] * rq, xq[7] * rq);
            o1.x = pk2(xq[8] * rq, xq[9] * rq); o1.y = pk2(xq[10] * rq, xq[11] * rq); o1.z = pk2(xq[12] * rq, xq[13] * rq); o1.w = pk2(xq[14] * rq, xq[15] * rq);
            *(u32x4*)(QN + i * 136 + 16 * seg) = o0; *(u32x4*)(QN + i * 136 + 16 * seg + 8) = o1;
            o0.x = pk2(xk[0] * rk, xk[1] * rk); o0.y = pk2(xk[2] * rk, xk[3] * rk); o0.z = pk2(xk[4] * rk, xk[5] * rk); o0.w = pk2(xk[6] * rk, xk[7] * rk);
            o1.x = pk2(xk[8] * rk, xk[9] * rk); o1.y = pk2(xk[10] * rk, xk[11] * rk); o1.z = pk2(xk[12] * rk, xk[13] * rk); o1.w = pk2(xk[14] * rk, xk[15] * rk);
            *(u32x4*)(KN + i * 136 + 16 * seg) = o0; *(u32x4*)(KN + i * 136 + 16 * seg + 8) = o1;
            if (wid == 0) {
                const float a = AB[(size_t)(t0 + lane) * 16 + h], bb = AB[(size_t)(t0 + lane) * 16 + 6 + h];
                const float xx = a + in[6][layer * 6 + h];
                const float sp = fmaxf(xx, 0.f) + log1pf(expf(-fabsf(xx)));
                float gc = -expf(in[5][layer * 6 + h]) * sp;
                const float beta = 1.f / (1.f + expf(-bb));
#pragma unroll
                for (int o = 1; o < 64; o <<= 1) { const float t = __shfl_up(gc, o); if (lane >= o) gc += t; }
                const float gl = __shfl(gc, 63);
                const float eg = expf(gc);
                s_gc[lane] = gc; s_beta[lane] = beta; s_eg[lane] = eg; s_ekd[lane] = expf(gl - gc); s_beg[lane] = beta * eg;
                if (lane == 63) ((float*)(ws + WS_CD))[ridx] = eg;
            }
        }
        __syncthreads();
        {
            const int which = wid >> 2, rt = wid & 3;
            const bf16_t* Asrc = which ? QN : KN;
            bf16x8 af[4];
#pragma unroll
            for (int s = 0; s < 4; ++s) af[s] = *(const bf16x8*)(Asrc + (16 * rt + c16) * 136 + 32 * s + 8 * q);
            float gi[4], bi[4];
#pragma unroll
            for (int r = 0; r < 4; ++r) { gi[r] = s_gc[16 * rt + 4 * q + r]; bi[r] = s_beta[16 * rt + 4 * q + r]; }
#pragma unroll
            for (int ct = 0; ct < 4; ++ct) {
                f32x4 acc = {0.f, 0.f, 0.f, 0.f};
#pragma unroll
                for (int s = 0; s < 4; ++s) { const bf16x8 bfr = *(const bf16x8*)(KN + (16 * ct + c16) * 136 + 32 * s + 8 * q); acc = MFMA16(af[s], bfr, acc); }
                const int j = 16 * ct + c16; const float gj = s_gc[j];
#pragma unroll
                for (int r = 0; r < 4; ++r) { const int i = 16 * rt + 4 * q + r;
                    const float dec = __expf(fminf(gi[r] - gj, 0.f));
                    if (which == 0) { const float lv = (j < i) ? acc[r] * dec * bi[r] : 0.f;
                        if (ct == rt) LD[rt * 256 + (4 * q + r) * 16 + c16] = lv;
                        NB[i * 72 + 32 * (j >> 5) + pos32(j & 31)] = f2bf(ct < rt ? -lv : 0.f); }
                    else RECI[24576 + i * 64 + 32 * (j >> 5) + pos32(j & 31)] = f2bf((j <= i) ? acc[r] * dec : 0.f); }
            }
        }
        __syncthreads();
        if (wid == 0) {
            const int blk = lane >> 4, c = lane & 15;
            int ldoff = PLS + blk * 1024; asm volatile("" : "+v"(ldoff));
            const float* Lb = (const float*)(smem + ldoff);
            float t[16];
            t[0] = (c == 0) ? 1.f : 0.f;
#pragma unroll
            for (int r = 1; r < 16; ++r) { float a = (c == r) ? 1.f : 0.f;
#pragma unroll
                for (int k = 0; k < r; ++k) a -= Lb[r * 16 + k] * t[k];
                t[r] = a; }
            bf16_t* ta = TA + blk * 640 + 8 * (c >> 2) + (c & 3);
#pragma unroll
            for (int r = 0; r < 16; ++r) { ta[r * 40] = f2bf(t[r]); ta[r * 40 + 4] = 0; }
        }
        {
            { const int i = tid >> 3, seg = tid & 7, g = seg >> 1, a = seg & 1; const float eg = s_eg[i];
                const u32x4 w0 = *(const u32x4*)(QN + i * 136 + 16 * seg), w1 = *(const u32x4*)(QN + i * 136 + 16 * seg + 8);
                u32x2 o;
                o.x = pk2(bflo(w0.x) * eg, bfhi(w0.x) * eg); o.y = pk2(bflo(w0.y) * eg, bfhi(w0.y) * eg); *(u32x2*)(RECI + 8192 + i * 128 + 32 * g + 4 * a) = o;
                o.x = pk2(bflo(w0.z) * eg, bfhi(w0.z) * eg); o.y = pk2(bflo(w0.w) * eg, bfhi(w0.w) * eg); *(u32x2*)(RECI + 8192 + i * 128 + 32 * g + 8 + 4 * a) = o;
                o.x = pk2(bflo(w1.x) * eg, bfhi(w1.x) * eg); o.y = pk2(bflo(w1.y) * eg, bfhi(w1.y) * eg); *(u32x2*)(RECI + 8192 + i * 128 + 32 * g + 16 + 4 * a) = o;
                o.x = pk2(bflo(w1.z) * eg, bfhi(w1.z) * eg); o.y = pk2(bflo(w1.w) * eg, bfhi(w1.w) * eg); *(u32x2*)(RECI + 8192 + i * 128 + 32 * g + 24 + 4 * a) = o; }
            { const int k = tid >> 2, js = tid & 3, g2 = js >> 1, a = js & 1;
                float v[16];
#pragma unroll
                for (int e = 0; e < 16; ++e) v[e] = bf2f(KN[(16 * js + e) * 136 + k]) * s_ekd[16 * js + e];
#pragma unroll
                for (int qq = 0; qq < 4; ++qq) { u32x2 o; o.x = pk2(v[4 * qq], v[4 * qq + 1]); o.y = pk2(v[4 * qq + 2], v[4 * qq + 3]); *(u32x2*)(RECI + 16384 + k * 64 + 32 * g2 + 8 * qq + 4 * a) = o; } }
        }
        __syncthreads();
        {
            f32x4 X[2][4]; bf16x8 Xb[2][2];
            const bf16x8 zero8 = {0, 0, 0, 0, 0, 0, 0, 0};
#pragma unroll
            for (int tl = 0; tl < 2; ++tl) { Xb[tl][0] = zero8; Xb[tl][1] = zero8; }
#pragma unroll
            for (int I = 0; I < 4; ++I) {
                const bf16x8 ta = *(const bf16x8*)(TA + I * 640 + c16 * 40 + 8 * q);
                bf16x8 na0 = zero8, na1 = zero8;
                if (I >= 1) na0 = *(const bf16x8*)(NB + (16 * I + c16) * 72 + 8 * q);
                if (I == 3) na1 = *(const bf16x8*)(NB + (16 * I + c16) * 72 + 32 + 8 * q);
#pragma unroll
                for (int tl = 0; tl < 2; ++tl) {
                    const bf16_t* src = (tl == 0 ? VB : KN) + 16 * wid + c16; const float* scl = tl == 0 ? s_beta : s_beg;
                    f32x4 y;
#pragma unroll
                    for (int r = 0; r < 4; ++r) { const int i = 16 * I + 4 * q + r; y[r] = bf2f(src[i * 136]) * scl[i]; }
                    if (I >= 1) y = MFMA16(na0, Xb[tl][0], y);
                    if (I == 3) y = MFMA16(na1, Xb[tl][1], y);
                    u32x4 w; w.x = pk2(y[0], y[1]); w.y = pk2(y[2], y[3]); w.z = 0u; w.w = 0u;
                    const f32x4 zf = {0.f, 0.f, 0.f, 0.f};
                    X[tl][I] = MFMA16(ta, __builtin_bit_cast(bf16x8, w), zf);
                    if (I == 0) { u32x4 p; p.x = pk2(X[tl][0][0], X[tl][0][1]); p.y = pk2(X[tl][0][2], X[tl][0][3]); p.z = 0u; p.w = 0u; Xb[tl][0] = __builtin_bit_cast(bf16x8, p); }
                    if (I == 1) { u32x4 p = __builtin_bit_cast(u32x4, Xb[tl][0]); p.z = pk2(X[tl][1][0], X[tl][1][1]); p.w = pk2(X[tl][1][2], X[tl][1][3]); Xb[tl][0] = __builtin_bit_cast(bf16x8, p); }
                    if (I == 2) { u32x4 p; p.x = pk2(X[tl][2][0], X[tl][2][1]); p.y = pk2(X[tl][2][2], X[tl][2][3]); p.z = 0u; p.w = 0u; Xb[tl][1] = __builtin_bit_cast(bf16x8, p); }
                }
            }
            { unsigned char* ut = ws + WS_UT + (size_t)ridx * 16384 + (size_t)(16 * wid + c16) * 128 + 8 * q;
#pragma unroll
                for (int I = 0; I < 4; ++I) { u32x2 o; o.x = pk2(X[0][I][0], X[0][I][1]); o.y = pk2(X[0][I][2], X[0][I][3]); *(u32x2*)(ut + 32 * I) = o; } }
            { const int kc = 16 * wid + c16, pc = 32 * (kc >> 5) + pos32(kc & 31);
#pragma unroll
                for (int I = 0; I < 4; ++I)
#pragma unroll
                    for (int r = 0; r < 4; ++r) RECI[(16 * I + 4 * q + r) * 128 + pc] = f2bf(-X[1][I][r]); }
        }
        __syncthreads();
        { const u32x4* s = (const u32x4*)smem; u32x4* d = (u32x4*)(ws + WS_REC + (size_t)ridx * REC_BYTES);
#pragma unroll
            for (int e = 0; e < 7; ++e) __builtin_nontemporal_store(s[tid + 512 * e], d + tid + 512 * e); }
        __syncthreads();
    }
}

constexpr int SA_W = 0, SA_KDT = 17408, SA_SZ = 35840;
DI unsigned char* sh_base(unsigned char* ws, int grp) { return ws + (grp < 10 ? WS_R1 + 64 * MiB + (size_t)grp * 8 * MiB : WS_END + (size_t)(grp - 10) * 8 * MiB); }
DI void scan_rec(const unsigned char* imga, unsigned char* shp, unsigned char* vbp, f32x4 (&S)[8], bf16x8 (&Sb)[4], const u32x2 (&u)[4], float cd, int c16, int q) {
    const unsigned char* pw = imga + SA_W + c16 * 272 + q * 16;
    const unsigned char* pk = imga + SA_KDT + c16 * 144 + q * 16;
    bf16x8 aw[4][4], ak[8][2];
#pragma unroll
    for (int g = 0; g < 4; ++g)
#pragma unroll
        for (int m = 0; m < 4; ++m) aw[g][m] = *(const bf16x8*)(pw + m * 16 * 272 + g * 64);
#pragma unroll
    for (int m = 0; m < 8; ++m) { ak[m][0] = *(const bf16x8*)(pk + m * 16 * 144); ak[m][1] = *(const bf16x8*)(pk + m * 16 * 144 + 64); }
    __builtin_amdgcn_sched_barrier(0);
    f32x4 acc[4];
#pragma unroll
    for (int m = 0; m < 4; ++m) acc[m] = (f32x4){bflo(u[m].x), bfhi(u[m].x), bflo(u[m].y), bfhi(u[m].y)};
#pragma unroll
    for (int g = 0; g < 4; ++g) __builtin_nontemporal_store(Sb[g], (bf16x8*)(shp + g * 1024));
#pragma unroll
    for (int g = 0; g < 4; ++g) {
#pragma unroll
        for (int m = 0; m < 4; ++m) acc[m] = MFMA16(aw[g][m], Sb[g], acc[m]);
        S[2 * g] = S[2 * g] * cd; S[2 * g + 1] = S[2 * g + 1] * cd;
    }
    bf16x8 Vb[2];
#pragma unroll
    for (int g = 0; g < 2; ++g) { u32x4 w; w.x = pk2(acc[2 * g][0], acc[2 * g][1]); w.y = pk2(acc[2 * g][2], acc[2 * g][3]); w.z = pk2(acc[2 * g + 1][0], acc[2 * g + 1][1]); w.w = pk2(acc[2 * g + 1][2], acc[2 * g + 1][3]);
        Vb[g] = __builtin_bit_cast(bf16x8, w); __builtin_nontemporal_store(Vb[g], (bf16x8*)(vbp + g * 1024)); }
#pragma unroll
    for (int g = 0; g < 2; ++g)
#pragma unroll
        for (int m = 0; m < 8; ++m) S[m] = MFMA16(ak[m][g], Vb[g], S[m]);
#pragma unroll
    for (int g = 0; g < 4; ++g) { u32x4 w; w.x = pk2(S[2 * g][0], S[2 * g][1]); w.y = pk2(S[2 * g][2], S[2 * g][3]); w.z = pk2(S[2 * g + 1][0], S[2 * g + 1][1]); w.w = pk2(S[2 * g + 1][2], S[2 * g + 1][3]);
        Sb[g] = __builtin_bit_cast(bf16x8, w); }
}
DI void scan_phase(unsigned char* ws, int grp, int eighth) {
    const int tid = opaque_tid(), lane = tid & 63, wid = __builtin_amdgcn_readfirstlane(tid >> 6), c16 = lane & 15, q = lane >> 4;
    grp = opaque_s(grp); eighth = opaque_s(eighth);
    const float* CD = (const float*)(ws + WS_CD);
    const unsigned char* REC = ws + WS_REC;
    const size_t item0 = (size_t)grp * 256;
#define CLAMP255(v) ((v) < 256 ? (v) : 255)
    if (wid == 0) {
        f32x4 S[8]; bf16x8 Sb[4];
#pragma unroll
        for (int m = 0; m < 8; ++m) S[m] = (f32x4){0.f, 0.f, 0.f, 0.f};
#pragma unroll
        for (int g = 0; g < 4; ++g) Sb[g] = (bf16x8){0, 0, 0, 0, 0, 0, 0, 0};
        const unsigned char* ut = ws + WS_UT + (size_t)(16 * eighth + c16) * 128 + 8 * q;
        unsigned char* shp = sh_base(ws, grp) + (size_t)eighth * 4096 + lane * 16;
        unsigned char* vbp = ws + WS_UT + item0 * 16384 + (size_t)eighth * 2048 + lane * 16;
        u32x2 uA[4], uB[4], uC[4], uD[4]; float cdA, cdB, cdC, cdD;
#define ULOAD(U, CDV, idx) do { const size_t it_ = item0 + (size_t)(idx); _Pragma("unroll") for (int m = 0; m < 4; ++m) U[m] = *(const u32x2*)(ut + it_ * 16384 + 32 * m); CDV = CD[it_]; } while (0)
        ULOAD(uA, cdA, 0); ULOAD(uB, cdB, 1); ULOAD(uC, cdC, 2); ULOAD(uD, cdD, 3);
        __syncthreads();
        for (int n = 0; n < 256; n += 4) {
            scan_rec(smem, shp + (size_t)n * 32768, vbp + (size_t)n * 16384, S, Sb, uA, cdA, c16, q);                       ULOAD(uA, cdA, CLAMP255(n + 4)); __syncthreads();
            scan_rec(smem + SA_SZ, shp + (size_t)(n + 1) * 32768, vbp + (size_t)(n + 1) * 16384, S, Sb, uB, cdB, c16, q);   ULOAD(uB, cdB, CLAMP255(n + 5)); __syncthreads();
            scan_rec(smem, shp + (size_t)(n + 2) * 32768, vbp + (size_t)(n + 2) * 16384, S, Sb, uC, cdC, c16, q);           ULOAD(uC, cdC, CLAMP255(n + 6)); __syncthreads();
            scan_rec(smem + SA_SZ, shp + (size_t)(n + 3) * 32768, vbp + (size_t)(n + 3) * 16384, S, Sb, uD, cdD, c16, q);   ULOAD(uD, cdD, CLAMP255(n + 7)); __syncthreads();
        }
#undef ULOAD
    } else if (wid == 1) {
        u32x4 pA[4], pB[4], pC[4], pD[4];
        const unsigned char* pfb = REC + item0 * REC_BYTES + (size_t)eighth * 2048 + lane * 16;
#define PFLOAD(P, idx) do { const unsigned char* s_ = pfb + (size_t)CLAMP255(idx) * REC_BYTES; P[0] = *(const u32x4*)s_; P[1] = *(const u32x4*)(s_ + 1024); P[2] = *(const u32x4*)(s_ + 32768); P[3] = *(const u32x4*)(s_ + 33792); } while (0)
#define PFDONE(P) do { _Pragma("unroll") for (int e = 0; e < 4; ++e) asm volatile("" :: "v"(P[e])); } while (0)
        PFLOAD(pA, 6); PFLOAD(pB, 7); PFLOAD(pC, 8); PFLOAD(pD, 9);
        __syncthreads();
        for (int n = 0; n < 256; n += 4) {
            PFDONE(pA); PFLOAD(pA, n + 10); __syncthreads();
            PFDONE(pB); PFLOAD(pB, n + 11); __syncthreads();
            PFDONE(pC); PFLOAD(pC, n + 12); __syncthreads();
            PFDONE(pD); PFLOAD(pD, n + 13); __syncthreads();
        }
        PFDONE(pA); PFDONE(pB); PFDONE(pC); PFDONE(pD);
#undef PFLOAD
#undef PFDONE
    } else {
        const int lt = tid - 128;
        int offA[6], recA[6];
#pragma unroll
        for (int e = 0; e < 6; ++e) { const int ia = lt + 384 * e, o = 16 * (ia & 1023);
            if (ia < 1024) { recA[e] = o; offA[e] = SA_W + (o >> 8) * 272 + (o & 255); } else { recA[e] = 32768 + o; offA[e] = SA_KDT + (o >> 7) * 144 + (o & 127); } }
        const bool a5 = (lt + 384 * 5) < 2048;
        u32x4 ra[6], rb[6], rc[6], rd[6];
#define RLOAD(R, idx) do { const unsigned char* s_ = REC + (item0 + (size_t)(idx)) * REC_BYTES; _Pragma("unroll") for (int e = 0; e < 6; ++e) if (e < 5 || a5) R[e] = *(const u32x4*)(s_ + recA[e]); } while (0)
#define ASTORE(R, img) do { _Pragma("unroll") for (int e = 0; e < 6; ++e) if (e < 5 || a5) *(u32x4*)(smem + (img) + offA[e]) = R[e]; } while (0)
        RLOAD(ra, 0); ASTORE(ra, 0);
        RLOAD(ra, 1); RLOAD(rb, 2); RLOAD(rc, 3); RLOAD(rd, 4);
        __syncthreads();
        for (int n = 0; n < 256; n += 4) {
            ASTORE(ra, SA_SZ); RLOAD(ra, CLAMP255(n + 5)); __syncthreads();
            ASTORE(rb, 0);     RLOAD(rb, CLAMP255(n + 6)); __syncthreads();
            ASTORE(rc, SA_SZ); RLOAD(rc, CLAMP255(n + 7)); __syncthreads();
            ASTORE(rd, 0);     RLOAD(rd, CLAMP255(n + 8)); __syncthreads();
        }
#undef RLOAD
#undef ASTORE
    }
#undef CLAMP255
}
constexpr int DO_QD = 0, DO_IN = 17408, DO_OUT = 26624;
DI void dnout_phase(const float* const* in, unsigned char* ws, int layer) {
    const int tid = opaque_tid(), lane = tid & 63, wid = __builtin_amdgcn_readfirstlane(tid >> 6), c16 = lane & 15, q = lane >> 4;
    const bf16_t* ZQ = (const bf16_t*)(ws + WS_R1); bf16_t* MIX = (bf16_t*)(ws + WS_HB);
    const float* normw = in[7] + layer * 128;
    const int oi = tid >> 3, oseg = tid & 7;
    float nw[16];
#pragma unroll
    for (int e = 0; e < 16; ++e) nw[e] = normw[16 * oseg + e];
    int soff[3], roff[3];
#pragma unroll
    for (int e = 0; e < 3; ++e) { const int p = tid + 512 * e;
        if (p < 1024) { const int o = 16 * p; roff[e] = 16384 + o; soff[e] = DO_QD + (o >> 8) * 272 + (o & 255); } else { const int o = 16 * (p - 1024); roff[e] = 49152 + o; soff[e] = DO_IN + (o >> 7) * 144 + (o & 127); } }
    const int bid0 = opaque_s((int)blockIdx.x), gdim = opaque_s((int)gridDim.x);
    u32x4 pr[3], pz0, pz1; bf16x8 pSb[4], pVb[2];
#define DN_FETCH(it_) do { if ((it_) < NITEM) { const int grp_ = (it_) % 12, n_ = (it_) / 12, b_ = grp_ / 6, h_ = grp_ - 6 * b_, ridx_ = grp_ * 256 + n_, trow_ = b_ * SEQ + n_ * 64; \
        const unsigned char* rec_ = ws + WS_REC + (size_t)ridx_ * REC_BYTES; _Pragma("unroll") for (int e = 0; e < 3; ++e) pr[e] = *(const u32x4*)(rec_ + roff[e]); \
        pz0 = *(const u32x4*)(ZQ + (size_t)(trow_ + oi) * 1024 + h_ * 128 + 16 * oseg); pz1 = *(const u32x4*)(ZQ + (size_t)(trow_ + oi) * 1024 + h_ * 128 + 16 * oseg + 8); \
        const unsigned char* shp_ = sh_base(ws, grp_) + (size_t)n_ * 32768 + (size_t)wid * 4096 + lane * 16; const unsigned char* vbp_ = ws + WS_UT + (size_t)ridx_ * 16384 + (size_t)wid * 2048 + lane * 16; \
        _Pragma("unroll") for (int g = 0; g < 4; ++g) pSb[g] = *(const bf16x8*)(shp_ + g * 1024); pVb[0] = *(const bf16x8*)vbp_; pVb[1] = *(const bf16x8*)(vbp_ + 1024); } } while (0)
    DN_FETCH(bid0);
    for (int item = bid0; item < NITEM; item += gdim) {
        const int grp = item % 12, n = item / 12, b = grp / 6, h = grp - 6 * b, trow = b * SEQ + n * 64;
#pragma unroll
        for (int e = 0; e < 3; ++e) *(u32x4*)(smem + soff[e]) = pr[e];
        const u32x4 z0 = pz0, z1 = pz1;
        bf16x8 Sb[4], Vb[2];
#pragma unroll
        for (int g = 0; g < 4; ++g) Sb[g] = pSb[g];
        Vb[0] = pVb[0]; Vb[1] = pVb[1];
        DN_FETCH(item + gdim);
        __syncthreads();
        {
            const unsigned char* pq = smem + DO_QD + c16 * 272 + q * 16;
            const unsigned char* pi = smem + DO_IN + c16 * 144 + q * 16;
            f32x4 ao[4];
#pragma unroll
            for (int m = 0; m < 4; ++m) ao[m] = (f32x4){0.f, 0.f, 0.f, 0.f};
#pragma unroll
            for (int g = 0; g < 4; ++g) {
                bf16x8 aq[4];
#pragma unroll
                for (int m = 0; m < 4; ++m) aq[m] = *(const bf16x8*)(pq + m * 16 * 272 + g * 64);
#pragma unroll
                for (int m = 0; m < 4; ++m) ao[m] = MFMA16(aq[m], Sb[g], ao[m]);
            }
#pragma unroll
            for (int g = 0; g < 2; ++g) {
                bf16x8 ai[4];
#pragma unroll
                for (int m = 0; m < 4; ++m) ai[m] = *(const bf16x8*)(pi + m * 16 * 144 + g * 64);
#pragma unroll
                for (int m = 0; m < 4; ++m) ao[m] = MFMA16(ai[m], Vb[g], ao[m]);
            }
#pragma unroll
            for (int m = 0; m < 4; ++m)
#pragma unroll
                for (int r = 0; r < 4; ++r) *(bf16_t*)(smem + DO_OUT + (16 * m + 4 * q + r) * 272 + (16 * wid + c16) * 2) = f2bf(ao[m][r]);
        }
        __syncthreads();
        {
            const u32x4 a0 = *(const u32x4*)(smem + DO_OUT + oi * 272 + 32 * oseg), a1 = *(const u32x4*)(smem + DO_OUT + oi * 272 + 32 * oseg + 16);
            float o[16], zz[16];
            o[0] = bflo(a0.x); o[1] = bfhi(a0.x); o[2] = bflo(a0.y); o[3] = bfhi(a0.y); o[4] = bflo(a0.z); o[5] = bfhi(a0.z); o[6] = bflo(a0.w); o[7] = bfhi(a0.w);
            o[8] = bflo(a1.x); o[9] = bfhi(a1.x); o[10] = bflo(a1.y); o[11] = bfhi(a1.y); o[12] = bflo(a1.z); o[13] = bfhi(a1.z); o[14] = bflo(a1.w); o[15] = bfhi(a1.w);
            zz[0] = bflo(z0.x); zz[1] = bfhi(z0.x); zz[2] = bflo(z0.y); zz[3] = bfhi(z0.y); zz[4] = bflo(z0.z); zz[5] = bfhi(z0.z); zz[6] = bflo(z0.w); zz[7] = bfhi(z0.w);
            zz[8] = bflo(z1.x); zz[9] = bfhi(z1.x); zz[10] = bflo(z1.y); zz[11] = bfhi(z1.y); zz[12] = bflo(z1.z); zz[13] = bfhi(z1.z); zz[14] = bflo(z1.w); zz[15] = bfhi(z1.w);
            float ss = 0.f;
#pragma unroll
            for (int e = 0; e < 16; ++e) ss += o[e] * o[e];
            ss += __shfl_xor(ss, 1); ss += __shfl_xor(ss, 2); ss += __shfl_xor(ss, 4);
            const float rr = 1.f / sqrtf(ss * (1.f / 128.f) + 1e-6f);
#pragma unroll
            for (int e = 0; e < 16; ++e) o[e] = o[e] * rr * nw[e] * (zz[e] * __builtin_amdgcn_rcpf(1.f + __expf(-zz[e])));
            u32x4 w0, w1;
            w0.x = pk2(o[0], o[1]); w0.y = pk2(o[2], o[3]); w0.z = pk2(o[4], o[5]); w0.w = pk2(o[6], o[7]);
            w1.x = pk2(o[8], o[9]); w1.y = pk2(o[10], o[11]); w1.z = pk2(o[12], o[13]); w1.w = pk2(o[14], o[15]);
            bf16_t* dst = MIX + (size_t)(trow + oi) * 1024 + h * 128 + 16 * oseg;
            *(u32x4*)dst = w0; *(u32x4*)(dst + 8) = w1;
        }
        __syncthreads();
    }
}

constexpr int AT_K = 0, AT_V = 36864;
template <bool MASK>
DI void attn16(bf16x8 qb0, bf16x8 qb1, float sink, int qi, bool first_block, int g_lo, int g_hi, f32x4 (&o)[4], int c16, int q) {
    f32x4 sc[16];
    const int qt_ = __builtin_amdgcn_readfirstlane(qi >> 4);
    const unsigned char* kp = smem + AT_K + c16 * 144 + q * 16;
    const unsigned char* vp = smem + AT_V + c16 * 528 + q * 16;
    bf16x8 kb[2][8];
#pragma unroll
    for (int t = 0; t < 4; ++t) { kb[0][2 * t] = *(const bf16x8*)(kp + t * 16 * 144); kb[0][2 * t + 1] = *(const bf16x8*)(kp + t * 16 * 144 + 64); }
    __builtin_amdgcn_sched_barrier(0);
#pragma unroll
    for (int grp = 0; grp < 4; ++grp) {
        if (grp < 3) {
#pragma unroll
            for (int t = 0; t < 4; ++t) { kb[(grp + 1) & 1][2 * t] = *(const bf16x8*)(kp + (4 * (grp + 1) + t) * 16 * 144); kb[(grp + 1) & 1][2 * t + 1] = *(const bf16x8*)(kp + (4 * (grp + 1) + t) * 16 * 144 + 64); }
        }
        __builtin_amdgcn_sched_barrier(0);
        if (MASK && (grp < g_lo || grp > g_hi)) {
#pragma unroll
            for (int t = 0; t < 4; ++t) sc[4 * grp + t] = (f32x4){-1e30f, -1e30f, -1e30f, -1e30f};
        } else
#pragma unroll
        for (int t = 0; t < 4; ++t) {
            const int kt = 4 * grp + t;
            f32x4 acc = {0.f, 0.f, 0.f, 0.f};
            acc = MFMA16(kb[grp & 1][2 * t], qb0, acc); acc = MFMA16(kb[grp & 1][2 * t + 1], qb1, acc);
            if (MASK && !(kt > qt_ && kt < qt_ + 8 && (!first_block || kt >= 8))) {
#pragma unroll
                for (int r = 0; r < 4; ++r) { const int kj = 16 * kt + 4 * q + r, diff = qi + 128 - kj;
                    const bool valid = (diff >= 0) && (diff < 128) && (!first_block || kj >= 128);
                    acc[r] = valid ? acc[r] : -1e30f; }
            }
            sc[kt] = acc;
        }
        __builtin_amdgcn_sched_barrier(0);
    }
    bf16x8 vb[2][8];
#pragma unroll
    for (int gg = 0; gg < 2; ++gg)
#pragma unroll
        for (int dt = 0; dt < 4; ++dt) vb[0][4 * gg + dt] = *(const bf16x8*)(vp + dt * 16 * 528 + gg * 64);
    float m = sink;
#pragma unroll
    for (int kt = 0; kt < 16; ++kt) m = fmaxf(m, fmaxf(fmaxf(sc[kt][0], sc[kt][1]), fmaxf(sc[kt][2], sc[kt][3])));
    m = fmaxf(m, __shfl_xor(m, 16)); m = fmaxf(m, __shfl_xor(m, 32));
    float sum = 0.f;
#pragma unroll
    for (int kt = 0; kt < 16; ++kt) {
        if (MASK && ((kt >> 2) < g_lo || (kt >> 2) > g_hi)) sc[kt] = (f32x4){0.f, 0.f, 0.f, 0.f};
        else {
#pragma unroll
            for (int r = 0; r < 4; ++r) { const float pv = __expf(sc[kt][r] - m); sc[kt][r] = pv; sum += pv; } } }
    sum += __shfl_xor(sum, 16); sum += __shfl_xor(sum, 32);
    const float inv = 1.f / (sum + __expf(sink - m));
#pragma unroll
    for (int dt = 0; dt < 4; ++dt) o[dt] = (f32x4){0.f, 0.f, 0.f, 0.f};
    __builtin_amdgcn_sched_barrier(0);
#pragma unroll
    for (int grp = 0; grp < 4; ++grp) {
        if (grp < 3) {
#pragma unroll
            for (int gg = 0; gg < 2; ++gg)
#pragma unroll
                for (int dt = 0; dt < 4; ++dt) vb[(grp + 1) & 1][4 * gg + dt] = *(const bf16x8*)(vp + dt * 16 * 528 + (2 * (grp + 1) + gg) * 64);
        }
        __builtin_amdgcn_sched_barrier(0);
        if (!MASK || (grp >= g_lo && grp <= g_hi))
#pragma unroll
        for (int gg = 0; gg < 2; ++gg) { const int g = 2 * grp + gg;
            u32x4 w; w.x = pk2(sc[2 * g][0], sc[2 * g][1]); w.y = pk2(sc[2 * g][2], sc[2 * g][3]); w.z = pk2(sc[2 * g + 1][0], sc[2 * g + 1][1]); w.w = pk2(sc[2 * g + 1][2], sc[2 * g + 1][3]);
            const bf16x8 pb = __builtin_bit_cast(bf16x8, w);
#pragma unroll
            for (int dt = 0; dt < 4; ++dt) o[dt] = MFMA16(vb[grp & 1][4 * gg + dt], pb, o[dt]);
        }
        __builtin_amdgcn_sched_barrier(0);
    }
#pragma unroll
    for (int dt = 0; dt < 4; ++dt) o[dt] = o[dt] * inv;
}
DI void store_o(bf16_t* dst, const f32x4 (&o)[4], int q) {
#pragma unroll
    for (int dt = 0; dt < 4; ++dt) { u32x2 w; w.x = pk2(o[dt][0], o[dt][1]); w.y = pk2(o[dt][2], o[dt][3]); *(u32x2*)(dst + 16 * dt + 4 * q) = w; }
}
DI void memattn_phase(unsigned char* ws, int layer, int first, int stride) {
    first = opaque_s(first); stride = opaque_s(stride);
    const int tid = opaque_tid(), lane = tid & 63, wid = __builtin_amdgcn_readfirstlane(tid >> 6), c16 = lane & 15, q = lane >> 4;
    const bf16_t* KVM = (const bf16_t*)(ws + WS_KVMEM);
    const bf16_t* QP = (const bf16_t*)(ws + WS_R1);
    bf16_t* MIX = (bf16_t*)(ws + WS_HB);
    for (int item = first; item < 256; item += stride) {
        const int b = item >> 7, h = (item >> 5) & 3, rng = item & 31;
#pragma unroll
        for (int e = 0; e < 4; ++e) { const int ch = tid + 512 * e, mk = ch >> 3, c8 = ch & 7;
            const bf16_t* rowp = KVM + (size_t)(b * 256 + mk) * 2048 + layer * 512 + h * 64 + 8 * c8;
            *(u32x4*)(smem + AT_K + mk * 144 + 16 * c8) = *(const u32x4*)rowp;
            const u32x4 v = *(const u32x4*)(rowp + 256);
            const int pk = 32 * (mk >> 5) + pos32(mk & 31);
            bf16_t* vt = (bf16_t*)(smem + AT_V) + (8 * c8) * 264 + pk;
            vt[0] = (bf16_t)(v.x & 0xffffu); vt[264] = (bf16_t)(v.x >> 16); vt[2 * 264] = (bf16_t)(v.y & 0xffffu); vt[3 * 264] = (bf16_t)(v.y >> 16);
            vt[4 * 264] = (bf16_t)(v.z & 0xffffu); vt[5 * 264] = (bf16_t)(v.z >> 16); vt[6 * 264] = (bf16_t)(v.w & 0xffffu); vt[7 * 264] = (bf16_t)(v.w >> 16); }
        __syncthreads();
        u32x4 nr0, nr1;
        { const bf16_t* qp = QP + (size_t)(b * SEQ + rng * 512 + wid * 16 + c16) * 1024 + 768 + h * 64 + 8 * q; nr0 = *(const u32x4*)qp; nr1 = *(const u32x4*)(qp + 32); }
        for (int tile = wid; tile < 32; tile += 8) {
            const int tok = b * SEQ + rng * 512 + tile * 16 + c16;
            const u32x4 r0 = nr0, r1 = nr1;
            if (tile + 8 < 32) { const bf16_t* qp = QP + (size_t)(tok + 128) * 1024 + 768 + h * 64 + 8 * q; nr0 = *(const u32x4*)qp; nr1 = *(const u32x4*)(qp + 32); }
            u32x4 s0, s1;
            s0.x = pk2(bflo(r0.x) * 0.125f, bfhi(r0.x) * 0.125f); s0.y = pk2(bflo(r0.y) * 0.125f, bfhi(r0.y) * 0.125f); s0.z = pk2(bflo(r0.z) * 0.125f, bfhi(r0.z) * 0.125f); s0.w = pk2(bflo(r0.w) * 0.125f, bfhi(r0.w) * 0.125f);
            s1.x = pk2(bflo(r1.x) * 0.125f, bfhi(r1.x) * 0.125f); s1.y = pk2(bflo(r1.y) * 0.125f, bfhi(r1.y) * 0.125f); s1.z = pk2(bflo(r1.z) * 0.125f, bfhi(r1.z) * 0.125f); s1.w = pk2(bflo(r1.w) * 0.125f, bfhi(r1.w) * 0.125f);
            f32x4 o[4];
            attn16<false>(__builtin_bit_cast(bf16x8, s0), __builtin_bit_cast(bf16x8, s1), -1e30f, 0, false, 0, 3, o, c16, q);
            store_o(MIX + (size_t)tok * 1024 + 768 + h * 64, o, q);
        }
        __syncthreads();
    }
}
DI void swa_phase(const float* const* in, unsigned char* ws, int jb) {
    const int tid = opaque_tid(), lane = tid & 63, wid = __builtin_amdgcn_readfirstlane(tid >> 6), c16 = lane & 15, q = lane >> 4;
    const bf16_t* KVS = (const bf16_t*)(ws + WS_KVS);
    const bf16_t* QP = (const bf16_t*)(ws + WS_R1);
    const float* ROPE = (const float*)(ws + WS_ROPE);
    bf16_t* MIX = (bf16_t*)(ws + WS_HB);
    const float* sinks = in[9] + jb * 12;
    const int bid0 = opaque_s((int)blockIdx.x), gdim = opaque_s((int)gridDim.x);
    for (int it2 = 2 * bid0; it2 < 512; it2 += 2 * gdim)
    for (int item = it2; item < it2 + 2; ++item) {
        const int b = item >> 8, kvh = (item >> 7) & 1, blk = item & 127, t0 = b * SEQ + blk * 128;
#pragma unroll
        for (int e = 0; e < 2; ++e) { const int task = tid + 512 * e, kj = task >> 2, c = task & 3; const int t = t0 - 128 + kj;
            u32x4 o1 = {0u, 0u, 0u, 0u}, o2 = {0u, 0u, 0u, 0u};
            if (blk > 0 || kj >= 128) {
                const bf16_t* kp = KVS + (size_t)t * 256 + kvh * 64 + 8 * c;
                const u32x4 a = *(const u32x4*)kp, bq = *(const u32x4*)(kp + 32);
                const float* rp = ROPE + (size_t)t * 64 + 8 * c;
                const f32x4 c0 = *(const f32x4*)rp, c1 = *(const f32x4*)(rp + 4), s0 = *(const f32x4*)(rp + 32), s1 = *(const f32x4*)(rp + 36);
                float x1[8] = {bflo(a.x), bfhi(a.x), bflo(a.y), bfhi(a.y), bflo(a.z), bfhi(a.z), bflo(a.w), bfhi(a.w)};
                float x2[8] = {bflo(bq.x), bfhi(bq.x), bflo(bq.y), bfhi(bq.y), bflo(bq.z), bfhi(bq.z), bflo(bq.w), bfhi(bq.w)};
                float cs[8] = {c0.x, c0.y, c0.z, c0.w, c1.x, c1.y, c1.z, c1.w}, sn[8] = {s0.x, s0.y, s0.z, s0.w, s1.x, s1.y, s1.z, s1.w};
                float y1[8], y2[8];
#pragma unroll
                for (int i = 0; i < 8; ++i) { y1[i] = x1[i] * cs[i] - x2[i] * sn[i]; y2[i] = x2[i] * cs[i] + x1[i] * sn[i]; }
                o1.x = pk2(y1[0], y1[1]); o1.y = pk2(y1[2], y1[3]); o1.z = pk2(y1[4], y1[5]); o1.w = pk2(y1[6], y1[7]);
                o2.x = pk2(y2[0], y2[1]); o2.y = pk2(y2[2], y2[3]); o2.z = pk2(y2[4], y2[5]); o2.w = pk2(y2[6], y2[7]);
            }
            *(u32x4*)(smem + AT_K + kj * 144 + 16 * c) = o1; *(u32x4*)(smem + AT_K + kj * 144 + 64 + 16 * c) = o2; }
#pragma unroll
        for (int e = 0; e < 4; ++e) { const int ch = tid + 512 * e, kj = ch >> 3, c8 = ch & 7; const int t = t0 - 128 + kj;
            u32x4 v = {0u, 0u, 0u, 0u};
            if (blk > 0 || kj >= 128) v = *(const u32x4*)(KVS + (size_t)t * 256 + 128 + kvh * 64 + 8 * c8);
            const int pk = 32 * (kj >> 5) + pos32(kj & 31);
            bf16_t* vt = (bf16_t*)(smem + AT_V) + (8 * c8) * 264 + pk;
            vt[0] = (bf16_t)(v.x & 0xffffu); vt[264] = (bf16_t)(v.x >> 16); vt[2 * 264] = (bf16_t)(v.y & 0xffffu); vt[3 * 264] = (bf16_t)(v.y >> 16);
            vt[4 * 264] = (bf16_t)(v.z & 0xffffu); vt[5 * 264] = (bf16_t)(v.z >> 16); vt[6 * 264] = (bf16_t)(v.w & 0xffffu); vt[7 * 264] = (bf16_t)(v.w >> 16); }
        __syncthreads();
        u32x4 na, nb; f32x4 nc0, nc1, ns0, ns1;
#define SWA_QFETCH(task_) do { const int hh_ = (task_) >> 3, qt_ = (task_) & 7, head_ = kvh * 6 + hh_; const int tok_ = t0 + 16 * qt_ + c16; \
            const bf16_t* qp_ = QP + (size_t)tok_ * 1024 + head_ * 64 + 8 * q; na = *(const u32x4*)qp_; nb = *(const u32x4*)(qp_ + 32); \
            const float* rp_ = ROPE + (size_t)tok_ * 64 + 8 * q; nc0 = *(const f32x4*)rp_; nc1 = *(const f32x4*)(rp_ + 4); ns0 = *(const f32x4*)(rp_ + 32); ns1 = *(const f32x4*)(rp_ + 36); } while (0)
        SWA_QFETCH(wid);
        for (int task = wid; task < 48; task += 8) {
            const int hh = task >> 3, qt = task & 7, head = kvh * 6 + hh;
            const int tok = t0 + 16 * qt + c16;
            const u32x4 a = na, bq = nb; const f32x4 c0 = nc0, c1 = nc1, s0 = ns0, s1 = ns1;
            if (task + 8 < 48) SWA_QFETCH(task + 8);
            float x1[8] = {bflo(a.x), bfhi(a.x), bflo(a.y), bfhi(a.y), bflo(a.z), bfhi(a.z), bflo(a.w), bfhi(a.w)};
            float x2[8] = {bflo(bq.x), bfhi(bq.x), bflo(bq.y), bfhi(bq.y), bflo(bq.z), bfhi(bq.z), bflo(bq.w), bfhi(bq.w)};
            float cs[8] = {c0.x, c0.y, c0.z, c0.w, c1.x, c1.y, c1.z, c1.w}, sn[8] = {s0.x, s0.y, s0.z, s0.w, s1.x, s1.y, s1.z, s1.w};
            float y1[8], y2[8];
#pragma unroll
            for (int i = 0; i < 8; ++i) { y1[i] = (x1[i] * cs[i] - x2[i] * sn[i]) * 0.125f; y2[i] = (x2[i] * cs[i] + x1[i] * sn[i]) * 0.125f; }
            u32x4 o1, o2;
            o1.x = pk2(y1[0], y1[1]); o1.y = pk2(y1[2], y1[3]); o1.z = pk2(y1[4], y1[5]); o1.w = pk2(y1[6], y1[7]);
            o2.x = pk2(y2[0], y2[1]); o2.y = pk2(y2[2], y2[3]); o2.z = pk2(y2[4], y2[5]); o2.w = pk2(y2[6], y2[7]);
            f32x4 o[4];
            attn16<true>(__builtin_bit_cast(bf16x8, o1), __builtin_bit_cast(bf16x8, o2), sinks[head], 16 * qt + c16, blk == 0, blk == 0 ? 2 : (qt >> 2), (qt + 8) >> 2, o, c16, q);
            store_o(MIX + (size_t)tok * 1024 + head * 64, o, q);
        }
#undef SWA_QFETCH
        __syncthreads();
    }
}

#define XB_TMO      128
#define XB_XCNT(j)  (256  + 64 * (j))
#define XB_XSUB(j)  (1280 + 64 * (j))
#define XB_XGEN(j)  (2304 + 64 * (j))
#define XB_TOP      3328
#define XB_TOPGEN   3392
#define XCD_BAR_WORDS 3456
#define XB_SPIN_CAP (1u << 18)
#define LAS __attribute__((address_space(3)))

__device__ __forceinline__ unsigned xb_ld(unsigned* p)              { return __hip_atomic_load(p, __ATOMIC_RELAXED, __HIP_MEMORY_SCOPE_AGENT); }
__device__ __forceinline__ unsigned xb_add(unsigned* p, unsigned v) { return __hip_atomic_fetch_add(p, v, __ATOMIC_RELAXED, __HIP_MEMORY_SCOPE_AGENT); }
__device__ __forceinline__ unsigned xb_xcc_id() { return (unsigned)__builtin_amdgcn_s_getreg((3 << 11) | 20) & 0xFu; }
#define XB_SPIN(cond, bar) do { unsigned _sp = 0; while (cond) { __builtin_amdgcn_s_sleep(1); \
    if ((++_sp & 255u) == 0u) { if (xb_ld(&(bar)[XB_TMO])) break; if (_sp > XB_SPIN_CAP) { atomicAdd(&(bar)[XB_TMO], 1u); break; } } } } while (0)

struct XcdBarrier {
    unsigned* bar; unsigned x;
    volatile LAS unsigned* st;
};

__device__ __forceinline__ XcdBarrier xcd_barrier_post(unsigned* bar, volatile LAS unsigned* st) {
    XcdBarrier b; b.bar = bar; b.x = xb_xcc_id(); b.st = st;
    if (threadIdx.x == 0) (void)xb_add(&bar[XB_XCNT(b.x)], 1u);
    return b;
}
__device__ __forceinline__ void xcd_barrier_complete(unsigned* bar, unsigned x, unsigned& nloc, unsigned& nx) {
    const unsigned G = gridDim.x * gridDim.y * gridDim.z;
    unsigned sum, cnt, mine, sp = 0u;
    for (;;) {
        sum = 0u; cnt = 0u; mine = 0u;
#pragma unroll
        for (unsigned j = 0; j < 16; ++j) { const unsigned c = xb_ld(&bar[XB_XCNT(j)]); sum += c; cnt += (c > 0u) ? 1u : 0u; mine = (j == x) ? c : mine; }
        if (sum == G) break;
        __builtin_amdgcn_s_sleep(1);
        if ((++sp & 255u) == 0u) { if (xb_ld(&bar[XB_TMO])) break; if (sp > XB_SPIN_CAP) { atomicAdd(&bar[XB_TMO], 1u); break; } }
    }
    nloc = mine > 0u ? mine : 1u; nx = cnt > 0u ? cnt : 1u;
}

__device__ __forceinline__ void xcd_barrier(const XcdBarrier& b) {
    asm volatile("s_waitcnt vmcnt(0)" ::: "memory");
    __syncthreads();
    if (threadIdx.x == 0) {
        unsigned* bar = b.bar;
        __builtin_amdgcn_s_waitcnt(0);
        unsigned nloc = b.st[0], nx = b.st[1];
        if (nloc == 0u) { xcd_barrier_complete(bar, b.x, nloc, nx); b.st[0] = nloc; b.st[1] = nx; }
        const unsigned old = xb_add(&bar[XB_XSUB(b.x)], 1u);
        const unsigned gen = old / nloc;
        if (old + 1u == (gen + 1u) * nloc) {
            __builtin_amdgcn_fence(__ATOMIC_RELEASE, "agent");
            asm volatile("s_waitcnt vmcnt(0)" ::: "memory");
            const unsigned og = xb_add(&bar[XB_TOP], 1u);
            const unsigned tg = og / nx;
            if (og + 1u == (tg + 1u) * nx) xb_add(&bar[XB_TOPGEN], 1u);
            else XB_SPIN(xb_ld(&bar[XB_TOPGEN]) == tg, bar);
            __builtin_amdgcn_fence(__ATOMIC_ACQUIRE, "agent");
            xb_add(&bar[XB_XGEN(b.x)], 1u);
            asm volatile("s_waitcnt vmcnt(0)" ::: "memory");
        } else {
            XB_SPIN(xb_ld(&bar[XB_XGEN(b.x)]) == gen, bar);
            __builtin_amdgcn_fence(__ATOMIC_ACQUIRE, "agent");
            asm volatile("s_waitcnt vmcnt(0)" ::: "memory");
        }
    }
    __syncthreads();
}


struct Params { const float* in[17]; float* out; unsigned char* ws; int ph_lo, ph_hi; };
template <class Epi> DI void run_gemm(const bf16_t* A, const bf16_t* Bt, int M, int N, int K, const Epi& E) {
    pg8::Gemm g{A, Bt, M, N, K}; pg8::StaticOrder S; S.init(M, N, opaque_s((int)gridDim.x), opaque_s((int)blockIdx.x));
    pg8::gemm_phase<Epi, pg8::StaticOrder, false>((PG8_LAS unsigned char*)smem, g, S, E, nullptr);
}
template <class Epi> DI void run_gemm_sub(const bf16_t* A, const bf16_t* Bt, int M, int N, int K, const Epi& E, int G, int c) {
    pg8::Gemm g{A, Bt, M, N, K}; pg8::StaticOrder S; S.init(M, N, opaque_s(G), opaque_s(c));
    pg8::gemm_phase<Epi, pg8::StaticOrder, false>((PG8_LAS unsigned char*)smem, g, S, E, nullptr);
}
__global__ void __launch_bounds__(512, 2) yoco_fwd(Params p) {
    cg::grid_group grid = cg::this_grid();
    __shared__ uint4 xb_words;
    if (threadIdx.x == 0) xb_words = make_uint4(0u, 0u, 0u, 0u);
    __syncthreads();
    const XcdBarrier xbar = xcd_barrier_post((unsigned*)p.ws, (volatile LAS unsigned*)&xb_words);
    int ph = 0;
#define PHASE_BEGIN if (ph >= p.ph_lo && ph < p.ph_hi) { unsigned char* ws = opaque_ptr(p.ws); bf16_t* HB = (bf16_t*)(ws + WS_HB); const int tid = opaque_tid(), lane = tid & 63, wid = __builtin_amdgcn_readfirstlane(tid >> 6); const int gw = opaque_s((int)blockIdx.x) * 8 + wid, ngw = opaque_s((int)gridDim.x) * 8; float* scr = (float*)smem + wid * (64 * 33); (void)HB; (void)gw; (void)ngw; (void)scr; (void)lane;
#define PHASE_END   if (ph + 1 < p.ph_hi) { if (p.ph_lo < 0) grid.sync();   xcd_barrier(xbar); } } ++ph;
    PHASE_BEGIN
        row_pass<false, false, true>(p.in[0], nullptr, HB, nullptr, nullptr, p.in[3], (float*)(ws + WS_AB), gw, ngw, lane);
        __syncthreads();
        convert_small_weights(p.in, ws, 0, gw, ngw, lane, scr);
        for (int i = gw * 64 + lane; i < T * 32; i += ngw * 64) { const int t = i >> 5, f = i & 31;
            const float invf = exp2f(-(float)f * (13.287712379549449f / 32.f));
            const float ang = (float)((const int*)p.in[2])[t] * invf;
            double rev = (double)ang * 0.15915494309189535; rev -= __builtin_rint(rev);
            const float rv = (float)rev;
            float* rp = (float*)(ws + WS_ROPE) + (size_t)t * 64 + f; rp[0] = __builtin_amdgcn_cosf(rv); rp[32] = __builtin_amdgcn_sinf(rv); }
        for (int i = gw * 64 + lane; i < 512 * 1024 / 4; i += ngw * 64) { const f32x4 v = ((const f32x4*)p.in[1])[i]; u32x2 w; w.x = pk2(v.x, v.y); w.y = pk2(v.z, v.w); ((u32x2*)(ws + WS_MEMB))[i] = w; }
    PHASE_END
#pragma unroll 1
    for (int layer = 0; layer < 4; ++layer) {
        const bool isA = layer < 2;
        if (isA) {
            PHASE_BEGIN
                run_gemm(HB, (const bf16_t*)(ws + WS_WA1) + (size_t)layer * 2304 * 1024, T, 2304, 1024, pg8::EpiBf16<0>{(bf16_t*)(ws + WS_R1), 2304});
                if (layer == 0) run_gemm_sub((const bf16_t*)(ws + WS_MEMB), (const bf16_t*)(ws + WS_WMKV), 512, 2048, 1024, pg8::EpiBf16<0>{(bf16_t*)(ws + WS_KVMEM), 2048}, (int)gridDim.x, (int)((blockIdx.x + gridDim.x / 2) % gridDim.x));
            PHASE_END
            PHASE_BEGIN
                prep_phase(p.in, ws, layer);
            PHASE_END
            PHASE_BEGIN
                {
                    const int bid = opaque_s((int)blockIdx.x), x = bid & 7, k = bid >> 3;
                    int grp = -1, eighth = 0, midx = bid - 96;
                    if (bid < 128) { if (x < 4) { grp = 2 * x + (k >> 3); eighth = k & 7; } else if (k < 8) { grp = 8 + (x - 4); eighth = k; } else midx = (x - 4) * 8 + (k - 8); }
                    if (grp >= 0) scan_phase(ws, grp, eighth);
                    else { run_gemm_sub(HB, (const bf16_t*)(ws + WS_WA2) + (size_t)layer * 1024 * 1024, T, 1024, 1024, pg8::EpiBf16<0>{(bf16_t*)(ws + WS_R1), 1024}, (int)gridDim.x - 96, midx);
                        const int gw2 = midx * 8 + wid, ngw2 = ((int)gridDim.x - 96) * 8;
                        if (layer == 0) convert_small_weights(p.in, ws, 1, gw2, ngw2, lane, scr);
                        convert_mlp_weights(p.in, ws, layer, gw2, ngw2, lane, scr); }
                }
            PHASE_END
            PHASE_BEGIN
                dnout_phase(p.in, ws, layer);
                memattn_phase(ws, layer, blockIdx.x, gridDim.x);
            PHASE_END
        } else {
            PHASE_BEGIN
                run_gemm(HB, (const bf16_t*)(ws + WS_WB1) + (size_t)(layer - 2) * 1024 * 1024, T, 1024, 1024, pg8::EpiBf16<0>{(bf16_t*)(ws + WS_R1), 1024});
                if (layer == 2) run_gemm(HB, (const bf16_t*)(ws + WS_WKV), T, 256, 1024, pg8::EpiBf16<0>{(bf16_t*)(ws + WS_KVS), 256});
            PHASE_END
            PHASE_BEGIN
                swa_phase(p.in, ws, layer - 2);
                memattn_phase(ws, layer, blockIdx.x, gridDim.x);
            PHASE_END
        }
        PHASE_BEGIN
            run_gemm(HB, (const bf16_t*)(ws + WS_WO) + (size_t)layer * 1024 * 1024, T, 1024, 1024, pg8::EpiRes{layer == 0 ? p.in[0] : p.out, p.out, DN_ALPHA});
        PHASE_END
        PHASE_BEGIN
            row_pass<true, false, true>(p.out, nullptr, HB, p.in[15] + (size_t)(layer * 2) * 1024, p.in[16] + (size_t)(layer * 2) * 1024, nullptr, nullptr, gw, ngw, lane);
        PHASE_END
        PHASE_BEGIN
            run_gemm(HB, (const bf16_t*)(ws + WS_WUP), T, 4096, 1024, pg8::EpiBf16<3>{(bf16_t*)(ws + WS_R1), 4096});
        PHASE_END
        PHASE_BEGIN
            run_gemm((const bf16_t*)(ws + WS_R1), (const bf16_t*)(ws + WS_WDN), T, 1024, 4096, pg8::EpiResB{HB, p.out, DN_ALPHA});
        PHASE_END
        PHASE_BEGIN
            if (layer >= 1 && layer < 3) convert_mlp_weights(p.in, ws, layer + 1, gw, ngw, lane, scr);
            if (layer == 3) row_pass<true, true, false>(p.out, p.out, nullptr, p.in[15] + (size_t)(layer * 2 + 1) * 1024, p.in[16] + (size_t)(layer * 2 + 1) * 1024, nullptr, nullptr, gw, ngw, lane);
            else row_pass<true, true, true>(p.out, p.out, HB, p.in[15] + (size_t)(layer * 2 + 1) * 1024, p.in[16] + (size_t)(layer * 2 + 1) * 1024,
                                            layer == 0 ? p.in[3] + (size_t)1024 * 3340 : nullptr, (float*)(ws + WS_AB), gw, ngw, lane);
        PHASE_END
    }
}

extern "C" void kernel_launch(void* const* d_in, const int* in_sizes, int n_in, void* d_out, int out_size, void* d_ws, size_t ws_size, hipStream_t stream) {
    static int grid = 0;
    if (grid == 0) {
        int dev = 0, cus = 0, per_cu = 0;
        hipGetDevice(&dev); hipDeviceGetAttribute(&cus, hipDeviceAttributeMultiprocessorCount, dev);
        if (hipFuncSetAttribute((const void*)yoco_fwd, hipFuncAttributeMaxDynamicSharedMemorySize, LDS_BYTES) != hipSuccess) fprintf(stderr, "kernel_launch: hipFuncSetAttribute failed\n");
        if (hipOccupancyMaxActiveBlocksPerMultiprocessor(&per_cu, (const void*)yoco_fwd, 512, LDS_BYTES) != hipSuccess || per_cu < 1) { fprintf(stderr, "kernel_launch: occupancy query says %d\n", per_cu); per_cu = 1; }
        (void)hipGetLastError();
        grid = cus * 1;
        if (ws_size < WS_END + 16 * MiB) fprintf(stderr, "kernel_launch: workspace too small: %zu < %zu\n", ws_size, (size_t)WS_END);
        if (n_in != 17) fprintf(stderr, "kernel_launch: expected 17 inputs, got %d\n", n_in);
    }
    Params p{};
    for (int i = 0; i < 17; ++i) p.in[i] = (const float*)d_in[i];
    p.out = (float*)d_out; p.ws = (unsigned char*)d_ws; p.ph_lo = 0; p.ph_hi = 1000;
    if (hipMemsetAsync(d_ws, 0, XCD_BAR_WORDS * 4, stream) != hipSuccess) fprintf(stderr, "kernel_launch: memset failed\n");
    void* args[] = {&p};
    hipError_t e = hipLaunchCooperativeKernel((const void*)yoco_fwd, dim3(grid), dim3(512), args, LDS_BYTES, stream);
    if (e != hipSuccess) fprintf(stderr, "cooperative launch failed: %s (grid %d)\n", hipGetErrorString(e), grid);
}
```

```cpp
#include <hip/hip_runtime.h>
#include <hip/hip_cooperative_groups.h>
#include <cstdio>
namespace cg = cooperative_groups;
#define DI __device__ __forceinline__
typedef unsigned short bf16_t;
typedef short bf16x8 __attribute__((ext_vector_type(8)));
typedef float f32x4 __attribute__((ext_vector_type(4)));
typedef float f32x2 __attribute__((ext_vector_type(2)));
typedef unsigned u32x4 __attribute__((ext_vector_type(4)));
typedef unsigned u32x2 __attribute__((ext_vector_type(2)));
typedef __bf16 bf16x2_t __attribute__((ext_vector_type(2)));
DI unsigned pk2(float lo, float hi) { f32x2 v = {lo, hi}; bf16x2_t b = __builtin_convertvector(v, bf16x2_t); return __builtin_bit_cast(unsigned, b); }
DI float bf2f(unsigned short b) { return __uint_as_float(((unsigned)b) << 16); }
DI float bflo(unsigned w) { return __uint_as_float(w << 16); }
DI float bfhi(unsigned w) { return __uint_as_float(w & 0xffff0000u); }
DI unsigned short f2bf(float f) { return (unsigned short)(pk2(f, 0.f) & 0xffffu); }
#define MFMA16(a, b, c) __builtin_amdgcn_mfma_f32_16x16x32_bf16((a), (b), (c), 0, 0, 0)
DI float wave_sum(float v) {
#pragma unroll
    for (int o = 1; o < 64; o <<= 1) v += __shfl_xor(v, o);
    return v;
}
DI int opaque_tid() { int t = (int)threadIdx.x; asm volatile("" : "+v"(t)); return t; }
DI int opaque_s(int v) { v = __builtin_amdgcn_readfirstlane(v); asm volatile("" : "+s"(v)); return v; }
template <class Tp> DI Tp* opaque_ptr(Tp* p) { asm volatile("" : "+s"(p)); return p; }
DI int pos32(int kk) { return 8 * ((kk >> 2) & 3) + 4 * (kk >> 4) + (kk & 3); }

constexpr int T = 32768, D = 1024, SEQ = 16384, NCHUNK = 512  , NITEM = NCHUNK * 6;
constexpr float DN_ALPHA = 1.6817928305074290f;
constexpr size_t MiB = (size_t)1 << 20;
constexpr size_t WS_WA1 = 1 * MiB, WS_WA2 = WS_WA1 + 9 * MiB, WS_WB1 = WS_WA2 + 4 * MiB, WS_WKV = WS_WB1 + 4 * MiB, WS_WMKV = WS_WKV + 1 * MiB,
                 WS_WO = WS_WMKV + 4 * MiB, WS_WUP = WS_WO + 8 * MiB, WS_WDN = WS_WUP + 8 * MiB, WS_WAB = WS_WDN + 8 * MiB, WS_ROPE = WS_WAB + 1 * MiB,
                 WS_MEMB = WS_ROPE + 8 * MiB, WS_KVMEM = WS_MEMB + 1 * MiB, WS_AB = WS_KVMEM + 2 * MiB, WS_CD = WS_AB + 2 * MiB, WS_HB = WS_CD + 1 * MiB,
                 WS_R1 = WS_HB + 64 * MiB, WS_R2 = WS_R1 + 144 * MiB, WS_END = WS_R2 + 216 * MiB;
constexpr size_t WS_UT = WS_R2, WS_REC = WS_R2 + 48 * MiB, WS_KVS = WS_R2 + 200 * MiB;
constexpr int REC_BYTES = 57344, LDS_BYTES = 147456;
namespace pg8 {
#define PG8_LAS __attribute__((address_space(3)))
typedef unsigned short bf16_t;
typedef short bf16x8 __attribute__((ext_vector_type(8)));
typedef float f32x4 __attribute__((ext_vector_type(4)));
typedef unsigned u32x4 __attribute__((ext_vector_type(4)));
constexpr int BM = 256, BK = 64, HALF = 128, HTB = HALF * BK * 2  , STAGE_BYTES = 8 * HTB, NXCD = 8, WGM = 8;

__host__ __device__ __forceinline__ int lds_byte(int r, int c) { const int st = (r >> 4) * 2 + (c >> 5), rr = r & 15, cc = c & 31, ob = rr * 64 + cc * 2; return st * 1024 + (ob ^ (((ob >> 9) & 1) << 5)); }
__host__ __device__ __forceinline__ void stage_rc(int b, int& R, int& C) { const int st = b / 1024, sb = b % 1024, swz = sb ^ (((sb >> 9) & 1) << 5); R = (st >> 1) * 16 + swz / 64; C = (st & 1) * 32 + (swz % 64) / 2; }
__host__ __device__ __forceinline__ int perm32(int rho) { const int n = rho >> 4, i = rho & 15; return 8 * (i >> 2) + 4 * n + (i & 3); }

struct Unit { int pm, pn; };
struct Gemm { const bf16_t* A; const bf16_t* Bt; int M, N, K; };

struct StaticOrder {
    int nM, nN, nwg, G, c;
    __host__ __device__ void init(int M, int N, int G_, int c_) { nM = M / BM; nN = N / BM; nwg = nM * nN; G = G_; c = c_; }
    __host__ __device__ bool next(int i, Unit& u) const {
        const long L = (long)i * G + c; if (L >= nwg) return false;
        int wgid = (int)L; { const int q = nwg / NXCD, r = nwg % NXCD, xcd = wgid % NXCD, off = wgid / NXCD; wgid = (xcd < r ? xcd * (q + 1) : r * (q + 1) + (xcd - r) * q) + off; }
        const int nig = WGM * nN, gid = wgid / nig, fm = gid * WGM, gsz = (nM - fm) < WGM ? (nM - fm) : WGM;
        u.pm = fm + ((wgid % nig) % gsz); u.pn = (wgid % nig) / gsz; return true;
    }
    __device__ __forceinline__ void a_ready(const Unit&) const {}
    __device__ __forceinline__ void done(const Unit&) const {}
};

struct EpiRes {
    static constexpr bool PERM = false, AFTER_DRAIN = false;
    const float* H; float* C; float alpha;
    __device__ __forceinline__ void operator()(const f32x4 (&acc)[2][2][4][2], const Unit& u, int wr, int wc, int fr, int fq) const {
        const int row0 = u.pm * BM + wr * 64 + fr, col0 = u.pn * BM + wc * 32 + 4 * fq;
#pragma unroll
        for (int ai = 0; ai < 2; ++ai)
#pragma unroll
            for (int m = 0; m < 4; ++m) { const size_t off = (size_t)(row0 + ai * HALF + m * 16) * 1024 + col0;
                f32x4 hv[2][2];
#pragma unroll
                for (int bj = 0; bj < 2; ++bj)
#pragma unroll
                    for (int n = 0; n < 2; ++n) hv[bj][n] = *(const f32x4*)(H + off + bj * HALF + n * 16);
#pragma unroll
                for (int bj = 0; bj < 2; ++bj)
#pragma unroll
                    for (int n = 0; n < 2; ++n) *(f32x4*)(C + off + bj * HALF + n * 16) = acc[ai][bj][m][n] + hv[bj][n] * alpha; }
    }
};
struct EpiResB {
    static constexpr bool PERM = false, AFTER_DRAIN = false;
    const bf16_t* Hb; float* C; float alpha;
    __device__ __forceinline__ void operator()(const f32x4 (&acc)[2][2][4][2], const Unit& u, int wr, int wc, int fr, int fq) const {
        const int row0 = u.pm * BM + wr * 64 + fr, col0 = u.pn * BM + wc * 32 + 4 * fq;
#pragma unroll
        for (int ai = 0; ai < 2; ++ai)
#pragma unroll
            for (int m = 0; m < 4; ++m) { const size_t off = (size_t)(row0 + ai * HALF + m * 16) * 1024 + col0;
                u32x2 hb[2][2];
#pragma unroll
                for (int bj = 0; bj < 2; ++bj)
#pragma unroll
                    for (int n = 0; n < 2; ++n) hb[bj][n] = *(const u32x2*)(Hb + off + bj * HALF + n * 16);
#pragma unroll
                for (int bj = 0; bj < 2; ++bj)
#pragma unroll
                    for (int n = 0; n < 2; ++n) { const f32x4 hv = {bflo(hb[bj][n].x), bfhi(hb[bj][n].x), bflo(hb[bj][n].y), bfhi(hb[bj][n].y)};
                        *(f32x4*)(C + off + bj * HALF + n * 16) = acc[ai][bj][m][n] + hv * alpha; } }
    }
};
template <int ACT  > struct EpiBf16 {
    static constexpr bool PERM = true, AFTER_DRAIN = false;
    bf16_t* O; int ldc;
    __device__ __forceinline__ void operator()(const f32x4 (&acc)[2][2][4][2], const Unit& u, int wr, int wc, int fr, int fq) const {
        const int row0 = u.pm * BM + wr * 64 + fr; const int col0 = u.pn * BM + wc * 32 + 8 * fq;
#pragma unroll
        for (int ai = 0; ai < 2; ++ai)
#pragma unroll
            for (int m = 0; m < 4; ++m) { bf16_t* rowp = O + (size_t)(row0 + ai * HALF + m * 16) * ldc + col0;
#pragma unroll
                for (int bj = 0; bj < 2; ++bj) { f32x4 v0 = acc[ai][bj][m][0], v1 = acc[ai][bj][m][1];
                    if (ACT == 3) {
#pragma unroll
                        for (int j = 0; j < 4; ++j) { const float a = fmaxf(v0[j], 0.f), b = fmaxf(v1[j], 0.f); v0[j] = a * a; v1[j] = b * b; } }
                    u32x4 w; w.x = pk2(v0[0], v0[1]); w.y = pk2(v0[2], v0[3]); w.z = pk2(v1[0], v1[1]); w.w = pk2(v1[2], v1[3]);
                    *(u32x4*)(rowp + bj * HALF) = w; } }
    }
};
template <class Epi, class Sched, bool STAMP = false>
__device__ __forceinline__ void gemm_phase(PG8_LAS unsigned char* lds, const Gemm g, const Sched& S, const Epi& E, unsigned long long* stamps) {
    const int tid = opaque_tid(), wid = __builtin_amdgcn_readfirstlane(tid >> 6), lane = tid & 63, wr = wid >> 2, wc = wid & 3, fr = lane & 15, fq = lane >> 4;
    const int K = g.K, nt = K / BK;
    int ts_lo = 0, ts_hi = 0, nts = 0; const unsigned long long rt_entry = STAMP ? (unsigned long long)wall_clock64() : 0ull;
#define PG8_STAMP() do { if (STAMP && wid == 0 && nts < 64) { const unsigned long long _c = (unsigned long long)clock64(); \
        ts_lo = (lane == nts) ? (int)(unsigned)_c : ts_lo; ts_hi = (lane == nts) ? (int)(unsigned)(_c >> 32) : ts_hi; ++nts; } } while (0)
    PG8_STAMP();
    unsigned voffA[2], voffB[2];
#pragma unroll
    for (int i = 0; i < 2; ++i) { int R, C; stage_rc(tid * 16 + i * 8192, R, C); const int Rb = Epi::PERM ? ((R & ~31) + perm32(R & 31)) : R;
        voffA[i] = (unsigned)(R * K + C) * 2u; voffB[i] = (unsigned)(Rb * K + C) * 2u; }
    const size_t kstep = (size_t)(BK * 2);
    const size_t hstep = (size_t)HALF * K * 2;
    const size_t tstep = 2 * hstep;
    const unsigned ldsw = (unsigned)wid * 1024u;
    const int aoff = lds_byte(wr * 64 + fr, fq * 8), boff = lds_byte(wc * 32 + fr, fq * 8);
#define PG8_SA(b, h) (((b) * 2 + (h)) * HTB)
#define PG8_SB(b, h) ((4 + (b) * 2 + (h)) * HTB)
#define PG8_STAGE(bufoff, gbase, voff) do { _Pragma("unroll") for (int _i = 0; _i < 2; ++_i) \
        __builtin_amdgcn_global_load_lds((const unsigned*)((const char*)(gbase) + (voff)[_i]), (PG8_LAS unsigned*)(lds + (bufoff) + ldsw + _i * 8192), 16, 0, 0); } while (0)
#define PG8_LDA(dst, b, h) do { _Pragma("unroll") for (int m = 0; m < 4; ++m) _Pragma("unroll") for (int k = 0; k < 2; ++k) dst[m][k] = *(const PG8_LAS bf16x8*)(lds + PG8_SA(b, h) + aoff + m * 2048 + k * 1024); } while (0)
#define PG8_LDB(dst, b, h) do { _Pragma("unroll") for (int n = 0; n < 2; ++n) _Pragma("unroll") for (int k = 0; k < 2; ++k) dst[n][k] = *(const PG8_LAS bf16x8*)(lds + PG8_SB(b, h) + boff + n * 2048 + k * 1024); } while (0)
#define PG8_MMA(ai, bj, At, Bt) do { __builtin_amdgcn_s_setprio(1); _Pragma("unroll") for (int m = 0; m < 4; ++m) _Pragma("unroll") for (int n = 0; n < 2; ++n) _Pragma("unroll") for (int k = 0; k < 2; ++k) \
        acc[ai][bj][m][n] = __builtin_amdgcn_mfma_f32_16x16x32_bf16(Bt[n][k], At[m][k], acc[ai][bj][m][n], 0, 0, 0); __builtin_amdgcn_s_setprio(0); } while (0)
#define PG8_WAIT_V(n) asm volatile("s_waitcnt vmcnt(" #n ")" ::: "memory")
#define PG8_WAIT_L(n) asm volatile("s_waitcnt lgkmcnt(" #n ")" ::: "memory")
#define PG8_BAR __builtin_amdgcn_s_barrier()
#define PG8_SCHED __builtin_amdgcn_sched_barrier(0)
    Unit cur, nxt; int ui = 0;
    if (!S.next(0, cur)) return;
    f32x4 acc[2][2][4][2];
#pragma unroll
    for (int a = 0; a < 2; ++a)
#pragma unroll
        for (int b = 0; b < 2; ++b)
#pragma unroll
            for (int m = 0; m < 4; ++m)
#pragma unroll
                for (int n = 0; n < 2; ++n) acc[a][b][m][n] = (f32x4){0.f, 0.f, 0.f, 0.f};
    bf16x8 At[4][2], B0[2][2], B1[2][2];
    const char* cA = (const char*)g.A + (size_t)cur.pm * tstep; const char* cB = (const char*)g.Bt + (size_t)cur.pn * tstep;
    S.a_ready(cur);
    PG8_STAGE(PG8_SB(0, 0), cB, voffB); PG8_STAGE(PG8_SA(0, 0), cA, voffA); PG8_STAGE(PG8_SB(0, 1), cB + hstep, voffB); PG8_STAGE(PG8_SA(0, 1), cA + hstep, voffA);
    if (wr == 1) PG8_BAR;
    PG8_WAIT_V(4); PG8_BAR;
    PG8_STAGE(PG8_SB(1, 0), cB + kstep, voffB); PG8_STAGE(PG8_SA(1, 0), cA + kstep, voffA); PG8_STAGE(PG8_SB(1, 1), cB + hstep + kstep, voffB);
    PG8_WAIT_V(6); PG8_BAR;
    PG8_STAMP();
    for (;;) {
        const bool has_next = S.next(ui + 1, nxt);
        const char* nA = has_next ? (const char*)g.A + (size_t)nxt.pm * tstep : cA; const char* nB = has_next ? (const char*)g.Bt + (size_t)nxt.pn * tstep : cB;
        for (int t = 0; t < nt; t += 2) {
            const bool last = (t == nt - 2);
            const char* a1 = cA + (size_t)(t + 1) * kstep;
            const char* a2 = last ? nA : cA + (size_t)(t + 2) * kstep; const char* b2 = last ? nB : cB + (size_t)(t + 2) * kstep;
            const char* a3 = a2 + kstep; const char* b3 = b2 + kstep;
            if (last && has_next) S.a_ready(nxt);
            PG8_LDB(B0, 0, 0); PG8_SCHED; PG8_LDA(At, 0, 0); PG8_STAGE(PG8_SA(1, 1), a1 + hstep, voffA);
            PG8_WAIT_L(8); PG8_BAR; PG8_WAIT_L(0); PG8_MMA(0, 0, At, B0); PG8_BAR; PG8_SCHED;
            PG8_LDB(B1, 0, 1); PG8_STAGE(PG8_SB(0, 0), b2, voffB);
            PG8_BAR; PG8_WAIT_L(0); PG8_MMA(0, 1, At, B1); PG8_BAR;
            PG8_LDA(At, 0, 1); PG8_STAGE(PG8_SA(0, 0), a2, voffA);
            PG8_BAR; PG8_WAIT_L(0); PG8_MMA(1, 0, At, B0); PG8_BAR; PG8_SCHED;
            PG8_STAGE(PG8_SB(0, 1), b2 + hstep, voffB);
            PG8_WAIT_V(6); PG8_BAR; PG8_MMA(1, 1, At, B1); PG8_BAR;
            PG8_LDB(B0, 1, 0); PG8_SCHED; PG8_LDA(At, 1, 0); PG8_STAGE(PG8_SA(0, 1), a2 + hstep, voffA);
            PG8_WAIT_L(8); PG8_BAR; PG8_WAIT_L(0); PG8_MMA(0, 0, At, B0); PG8_BAR; PG8_SCHED;
            PG8_LDB(B1, 1, 1); PG8_STAGE(PG8_SB(1, 0), b3, voffB);
            PG8_BAR; PG8_WAIT_L(0); PG8_MMA(0, 1, At, B1); PG8_BAR;
            PG8_LDA(At, 1, 1); PG8_STAGE(PG8_SA(1, 0), a3, voffA);
            PG8_BAR; PG8_WAIT_L(0); PG8_MMA(1, 0, At, B0); PG8_BAR; PG8_SCHED;
            PG8_STAGE(PG8_SB(1, 1), b3 + hstep, voffB);
            PG8_WAIT_V(6); PG8_BAR; PG8_MMA(1, 1, At, B1); PG8_BAR;
        }
        PG8_STAMP();
        if constexpr (!Epi::AFTER_DRAIN) { E(acc, cur, wr, wc, fr, fq); S.done(cur); }
        PG8_STAMP();
        if (!has_next) break;
#pragma unroll
        for (int a = 0; a < 2; ++a)
#pragma unroll
            for (int b = 0; b < 2; ++b)
#pragma unroll
                for (int m = 0; m < 4; ++m)
#pragma unroll
                    for (int n = 0; n < 2; ++n) acc[a][b][m][n] = (f32x4){0.f, 0.f, 0.f, 0.f};
        cur = nxt; cA = nA; cB = nB; ++ui;
    }
    PG8_WAIT_V(0);
    if (wr == 0) PG8_BAR;
    PG8_BAR;
    if constexpr (Epi::AFTER_DRAIN) { E.fused(acc, cur, wr, wc, fr, fq, lds, wid, lane); S.done(cur); }
    PG8_STAMP();
    if (STAMP && wid == 0) { stamps[lane] = lane < nts ? (((unsigned long long)(unsigned)ts_hi << 32) | (unsigned)ts_lo) : 0ull;
        if (lane == 62) stamps[62] = rt_entry; if (lane == 63) stamps[63] = (unsigned long long)wall_clock64(); }
#undef PG8_STAMP
#undef PG8_SA
#undef PG8_SB
#undef PG8_STAGE
#undef PG8_LDA
#undef PG8_LDB
#undef PG8_MMA
#undef PG8_WAIT_V
#undef PG8_WAIT_L
#undef PG8_BAR
#undef PG8_SCHED
}
}

extern __shared__ __attribute__((aligned(16))) unsigned char smem[];
#define LDS_WAIT() asm volatile("s_waitcnt lgkmcnt(0)" ::: "memory")

DI void transpose_item(const float* __restrict__ W, int ldw, int c0, int K, int nblk, bf16_t* WT, int r0, float* scr, int item, int lane) {
    const int kb = item / nblk, nb = item % nblk, k0 = 64 * kb, n0 = 32 * nb;
    float wv[32];
#pragma unroll
    for (int i = 0; i < 32; ++i) { const int kk = 2 * i + (lane >> 5); wv[i] = __builtin_nontemporal_load(W + (size_t)(k0 + kk) * ldw + c0 + n0 + (lane & 31)); }
#pragma unroll
    for (int i = 0; i < 32; ++i) { const int kk = 2 * i + (lane >> 5); scr[kk * 33 + (lane & 31)] = wv[i]; }
    LDS_WAIT();
    const int c = lane & 7;
#pragma unroll
    for (int j = 0; j < 4; ++j) { const int n = (lane >> 3) + 8 * j; const float* s = scr + (8 * c) * 33 + n;
        u32x4 o; o.x = pk2(s[0 * 33], s[1 * 33]); o.y = pk2(s[2 * 33], s[3 * 33]); o.z = pk2(s[4 * 33], s[5 * 33]); o.w = pk2(s[6 * 33], s[7 * 33]);
        *(u32x4*)(WT + (size_t)(r0 + n0 + n) * K + k0 + 8 * c) = o; }
    LDS_WAIT();
}
DI bool tjob(int& r, int nitems, const float* W, int ldw, int c0, int K, int nblk, bf16_t* WT, int r0, float* scr, int lane) {
    if (r < 0) return false;
    if (r < nitems) { transpose_item(W, ldw, c0, K, nblk, WT, r0, scr, r, lane); r = -1; return true; }
    r -= nitems; return false;
}
DI void convert_mlp_weights(const float* const* in, unsigned char* ws, int layer, int gw, int ngw, int lane, float* scr) {
    const float* up = in[13] + (size_t)layer * 1024 * 4096; const float* dn = in[14] + (size_t)layer * 4096 * 1024;
    for (int it = gw; it < 4096; it += ngw) {
        if (it < 2048) transpose_item(up, 4096, 0, 1024, 128, (bf16_t*)(ws + WS_WUP), 0, scr, it, lane);
        else transpose_item(dn, 1024, 0, 4096, 32, (bf16_t*)(ws + WS_WDN), 0, scr, it - 2048, lane);
    }
}
DI void convert_small_weights(const float* const* in, unsigned char* ws, int part, int gw, int ngw, int lane, float* scr) {
    if (part == 0) {
        constexpr int NIT = 1152 + 384 + 128 + 4 * 256;
        for (int it = gw; it < NIT; it += ngw) {
            int r = it;
            const float* w = in[3];
            tjob(r, 1152, w, 3340, 0, 1024, 72, (bf16_t*)(ws + WS_WA1), 0, scr, lane);
            tjob(r, 384, w, 3340, 2304, 1024, 24, (bf16_t*)(ws + WS_WA2), 0, scr, lane);
            tjob(r, 128, w, 3340, 3084, 1024, 8, (bf16_t*)(ws + WS_WA2), 768, scr, lane);
            for (int l = 0; l < 4; ++l) tjob(r, 256, in[11] + (size_t)l * 1024 * 512, 512, 0, 1024, 16, (bf16_t*)(ws + WS_WMKV), l * 512, scr, lane);
        }
    } else {
        constexpr int NIT = 1152 + 384 + 128 + 2 * 512 + 128 + 4 * 512;
        for (int it = gw; it < NIT; it += ngw) {
            int r = it;
            const float* w = in[3] + (size_t)1024 * 3340;
            tjob(r, 1152, w, 3340, 0, 1024, 72, (bf16_t*)(ws + WS_WA1) + (size_t)2304 * 1024, 0, scr, lane);
            tjob(r, 384, w, 3340, 2304, 1024, 24, (bf16_t*)(ws + WS_WA2) + (size_t)1024 * 1024, 0, scr, lane);
            tjob(r, 128, w, 3340, 3084, 1024, 8, (bf16_t*)(ws + WS_WA2) + (size_t)1024 * 1024, 768, scr, lane);
            for (int l = 0; l < 2; ++l) tjob(r, 512, in[8] + (size_t)l * 1024 * 1024, 1024, 0, 1024, 32, (bf16_t*)(ws + WS_WB1) + (size_t)l * 1024 * 1024, 0, scr, lane);
            tjob(r, 128, in[10], 256, 0, 1024, 8, (bf16_t*)(ws + WS_WKV), 0, scr, lane);
            for (int l = 0; l < 4; ++l) tjob(r, 512, in[12] + (size_t)l * 1024 * 1024, 1024, 0, 1024, 32, (bf16_t*)(ws + WS_WO) + (size_t)l * 1024 * 1024, 0, scr, lane);
        }
    }
}
template <bool DO_LN, bool WRITE_F32, bool WRITE_BF16>
DI void row_pass(const float* src, float* dstf, bf16_t* dstb, const float* g, const float* bta, const float* wab, float* ab, int gw, int ngw, int lane) {
    if (wab) {
        const int tid_ = opaque_tid();
#pragma unroll
        for (int e = 0; e < 2; ++e) { const int k = tid_ + 512 * e; const f32x4* wp = (const f32x4*)(wab + (size_t)k * 3340 + 3072); const f32x4 w0 = wp[0], w1 = wp[1], w2 = wp[2];
            float* sm = (float*)smem + k; sm[0] = w0.x; sm[1024] = w0.y; sm[2048] = w0.z; sm[3072] = w0.w; sm[4096] = w1.x; sm[5120] = w1.y; sm[6144] = w1.z; sm[7168] = w1.w; sm[8192] = w2.x; sm[9216] = w2.y; sm[10240] = w2.z; sm[11264] = w2.w; }
        __syncthreads();
    }
    f32x4 vn[4];
    if (gw < T) { const f32x4* xr = (const f32x4*)(src + (size_t)gw * D) + lane;
#pragma unroll
        for (int j = 0; j < 4; ++j) vn[j] = __builtin_nontemporal_load(xr + 64 * j); }
    for (int row = gw; row < T; row += ngw) {
        f32x4 v[4];
#pragma unroll
        for (int j = 0; j < 4; ++j) v[j] = vn[j];
        if (row + ngw < T) { const f32x4* xr = (const f32x4*)(src + (size_t)(row + ngw) * D) + lane;
#pragma unroll
            for (int j = 0; j < 4; ++j) vn[j] = __builtin_nontemporal_load(xr + 64 * j); }
        __builtin_amdgcn_sched_barrier(0);
        if (DO_LN) {
            float s = 0.f;
#pragma unroll
            for (int j = 0; j < 4; ++j) s += (v[j].x + v[j].y) + (v[j].z + v[j].w);
            const float mean = wave_sum(s) * (1.f / D); float s2 = 0.f;
#pragma unroll
            for (int j = 0; j < 4; ++j) { v[j] = v[j] - mean; s2 += (v[j].x * v[j].x + v[j].y * v[j].y) + (v[j].z * v[j].z + v[j].w * v[j].w); }
            const float rstd = 1.f / sqrtf(wave_sum(s2) * (1.f / D) + 1e-5f);
#pragma unroll
            for (int j = 0; j < 4; ++j) { const f32x4 gg = ((const f32x4*)g)[lane + 64 * j], bb = ((const f32x4*)bta)[lane + 64 * j]; v[j] = v[j] * rstd * gg + bb; }
        }
        if (WRITE_F32) { f32x4* o = (f32x4*)(dstf + (size_t)row * D) + lane;
#pragma unroll
            for (int j = 0; j < 4; ++j) __builtin_nontemporal_store(v[j], o + 64 * j); }
        if (WRITE_BF16) { u32x2* o = (u32x2*)(dstb + (size_t)row * D) + lane;
#pragma unroll
            for (int j = 0; j < 4; ++j) { u32x2 w; w.x = pk2(v[j].x, v[j].y); w.y = pk2(v[j].z, v[j].w); o[64 * j] = w; } }
        if (wab) {
            float a[16];
#pragma unroll
            for (int c = 0; c < 12; ++c) { float s = 0.f;
#pragma unroll
                for (int j = 0; j < 4; ++j) { const f32x4 w = ((const f32x4*)(smem + c * 4096))[lane + 64 * j]; s += (v[j].x * w.x + v[j].y * w.y) + (v[j].z * w.z + v[j].w * w.w); }
                a[c] = s; }
            a[12] = a[13] = a[14] = a[15] = 0.f;
            const bool h5 = (lane & 32) != 0, h4 = (lane & 16) != 0, h3 = (lane & 8) != 0, h2 = (lane & 4) != 0;
            float b8[8], b4[4], b2[2];
#pragma unroll
            for (int i = 0; i < 8; ++i) { const float keep = h5 ? a[8 + i] : a[i], send = h5 ? a[i] : a[8 + i]; b8[i] = keep + __shfl_xor(send, 32); }
#pragma unroll
            for (int i = 0; i < 4; ++i) { const float keep = h4 ? b8[4 + i] : b8[i], send = h4 ? b8[i] : b8[4 + i]; b4[i] = keep + __shfl_xor(send, 16); }
#pragma unroll
            for (int i = 0; i < 2; ++i) { const float keep = h3 ? b4[2 + i] : b4[i], send = h3 ? b4[i] : b4[2 + i]; b2[i] = keep + __shfl_xor(send, 8); }
            float r1 = (h2 ? b2[1] : b2[0]) + __shfl_xor(h2 ? b2[0] : b2[1], 4);
            r1 += __shfl_xor(r1, 2); r1 += __shfl_xor(r1, 1);
            const int idx = ((lane >> 5) & 1) * 8 + ((lane >> 4) & 1) * 4 + ((lane >> 3) & 1) * 2 + ((lane >> 2) & 1);
            if ((lane & 3) == 0 && idx < 12) ab[(size_t)row * 16 + idx] = r1;
        }
    }
}
constexpr int PX0 = 0, PX1 = 33792, PQN = 67584, PKN = PQN + 17408, PVB = PKN + 17408, PLS = PVB + 17408, PSM = PLS + 16384;
DI void prep_phase(const float* const* in, unsigned char* ws, int layer) {
    const int tid = opaque_tid(), lane = tid & 63, wid = __builtin_amdgcn_readfirstlane(tid >> 6), c16 = lane & 15, q = lane >> 4;
    float* X0 = (float*)(smem + PX0); float* X1 = (float*)(smem + PX1);
    bf16_t* QN = (bf16_t*)(smem + PQN); bf16_t* KN = (bf16_t*)(smem + PKN); bf16_t* VB = (bf16_t*)(smem + PVB);
    float* LD = (float*)(smem + PLS); bf16_t* NB = (bf16_t*)(smem + PLS + 4096); bf16_t* TA = (bf16_t*)(smem + 57344); float* SM = (float*)(smem + PSM);
    float* s_gc = SM, *s_beta = SM + 64, *s_eg = SM + 128, *s_ekd = SM + 192, *s_beg = SM + 256;
    bf16_t* RECI = (bf16_t*)smem;
    const bf16_t* QKV = (const bf16_t*)(ws + WS_R1);
    const float* AB = (const float*)(ws + WS_AB);
    const float* convw = in[4] + (size_t)layer * 4 * 2304;
    const int bid0 = opaque_s((int)blockIdx.x), gdim = opaque_s((int)gridDim.x);
    for (int item = bid0; item < NITEM; item += gdim) {
        const int h = item % 6, cidx = item / 6, t0 = cidx * 64, nloc = cidx & 255;
        const int ridx = ((cidx >> 8) * 6 + h) * 256 + nloc;
        if (tid < 384) {
            const int cgp = tid % 48, rb = tid / 48, ts = cgp >> 4, cc = (cgp & 15) * 8, col = ts * 768 + h * 128 + cc;
            f32x4 cw[4][2];
#pragma unroll
            for (int j = 0; j < 4; ++j) { cw[j][0] = *(const f32x4*)(convw + j * 2304 + col); cw[j][1] = *(const f32x4*)(convw + j * 2304 + col + 4); }
            u32x4 raw[11];
#pragma unroll
            for (int r = 0; r < 11; ++r) { const int rr = 8 * rb - 3 + r; raw[r] = (u32x4){0u, 0u, 0u, 0u};
                if (rr >= 0 || nloc != 0) raw[r] = *(const u32x4*)(QKV + (size_t)(t0 + rr) * 2304 + col); }
#pragma unroll
            for (int ro = 0; ro < 8; ++ro) {
                float y[8];
#pragma unroll
                for (int e = 0; e < 8; ++e) y[e] = 0.f;
#pragma unroll
                for (int j = 0; j < 4; ++j) { const u32x4 x = raw[ro + j];
                    y[0] += cw[j][0].x * bflo(x.x); y[1] += cw[j][0].y * bfhi(x.x); y[2] += cw[j][0].z * bflo(x.y); y[3] += cw[j][0].w * bfhi(x.y);
                    y[4] += cw[j][1].x * bflo(x.z); y[5] += cw[j][1].y * bfhi(x.z); y[6] += cw[j][1].z * bflo(x.w); y[7] += cw[j][1].w * bfhi(x.w); }
#pragma unroll
                for (int e = 0; e < 8; ++e) y[e] = y[e] * __builtin_amdgcn_rcpf(1.f + __expf(-y[e]));
                const int row = 8 * rb + ro;
                if (ts == 2) { u32x4 o; o.x = pk2(y[0], y[1]); o.y = pk2(y[2], y[3]); o.z = pk2(y[4], y[5]); o.w = pk2(y[6], y[7]); *(u32x4*)(VB + row * 136 + cc) = o; }
                else { float* X = (ts == 0 ? X0 : X1) + row * 132 + cc;
                    *(f32x4*)X = (f32x4){y[0], y[1], y[2], y[3]}; *(f32x4*)(X + 4) = (f32x4){y[4], y[5], y[6], y[7]}; }
            }
        }
        __syncthreads();
        {
            const int i = tid >> 3, seg = tid & 7;
            float xq[16], xk[16], sq = 0.f, sk = 0.f;
#pragma unroll
            for (int e4 = 0; e4 < 4; ++e4) { const f32x4 a = *(const f32x4*)(X0 + i * 132 + 16 * seg + 4 * e4), b = *(const f32x4*)(X1 + i * 132 + 16 * seg + 4 * e4);
                xq[4 * e4] = a.x; xq[4 * e4 + 1] = a.y; xq[4 * e4 + 2] = a.z; xq[4 * e4 + 3] = a.w; xk[4 * e4] = b.x; xk[4 * e4 + 1] = b.y; xk[4 * e4 + 2] = b.z; xk[4 * e4 + 3] = b.w; }
#pragma unroll
            for (int e = 0; e < 16; ++e) { sq += xq[e] * xq[e]; sk += xk[e] * xk[e]; }
            sq += __shfl_xor(sq, 1); sq += __shfl_xor(sq, 2); sq += __shfl_xor(sq, 4);
            sk += __shfl_xor(sk, 1); sk += __shfl_xor(sk, 2); sk += __shfl_xor(sk, 4);
            const float rq = (1.f / sqrtf(sq + 1e-6f)) * 0.08838834764831845f, rk = 1.f / sqrtf(sk + 1e-6f);
            u32x4 o0, o1;
            o0.x = pk2(xq[0] * rq, xq[1] * rq); o0.y = pk2(xq[2] * rq, xq[3] * rq); o0.z = pk2(xq[4] * rq, xq[5] * rq); o0.w = pk2(xq[6] * rq, xq[7] * rq);
            o1.x = pk2(xq[8] * rq, xq[9] * rq); o1.y = pk2(xq[10] * rq, xq[11] * rq); o1.z = pk2(xq[12] * rq, xq[13] * rq); o1.w = pk2(xq[14] * rq, xq[15] * rq);
            *(u32x4*)(QN + i * 136 + 16 * seg) = o0; *(u32x4*)(QN + i * 136 + 16 * seg + 8) = o1;
            o0.x = pk2(xk[0] * rk, xk[1] * rk); o0.y = pk2(xk[2] * rk, xk[3] * rk); o0.z = pk2(xk[4] * rk, xk[5] * rk); o0.w = pk2(xk[6] * rk, xk[7] * rk);
            o1.x = pk2(xk[8] * rk, xk[9] * rk); o1.y = pk2(xk[10] * rk, xk[11] * rk); o1.z = pk2(xk[12] * rk, xk[13] * rk); o1.w = pk2(xk[14] * rk, xk[15] * rk);
            *(u32x4*)(KN + i * 136 + 16 * seg) = o0; *(u32x4*)(KN + i * 136 + 16 * seg + 8) = o1;
            if (wid == 0) {
                const float a = AB[(size_t)(t0 + lane) * 16 + h], bb = AB[(size_t)(t0 + lane) * 16 + 6 + h];
                const float xx = a + in[6][layer * 6 + h];
                const float sp = fmaxf(xx, 0.f) + log1pf(expf(-fabsf(xx)));
                float gc = -expf(in[5][layer * 6 + h]) * sp;
                const float beta = 1.f / (1.f + expf(-bb));
#pragma unroll
                for (int o = 1; o < 64; o <<= 1) { const float t = __shfl_up(gc, o); if (lane >= o) gc += t; }
                const float gl = __shfl(gc, 63);
                const float eg = expf(gc);
                s_gc[lane] = gc; s_beta[lane] = beta; s_eg[lane] = eg; s_ekd[lane] = expf(gl - gc); s_beg[lane] = beta * eg;
                if (lane == 63) ((float*)(ws + WS_CD))[ridx] = eg;
            }
        }
        __syncthreads();
        {
            const int which = wid >> 2, rt = wid & 3;
            const bf16_t* Asrc = which ? QN : KN;
            bf16x8 af[4];
#pragma unroll
            for (int s = 0; s < 4; ++s) af[s] = *(const bf16x8*)(Asrc + (16 * rt + c16) * 136 + 32 * s + 8 * q);
            float gi[4], bi[4];
#pragma unroll
            for (int r = 0; r < 4; ++r) { gi[r] = s_gc[16 * rt + 4 * q + r]; bi[r] = s_beta[16 * rt + 4 * q + r]; }
#pragma unroll
            for (int ct = 0; ct < 4; ++ct) {
                f32x4 acc = {0.f, 0.f, 0.f, 0.f};
#pragma unroll
                for (int s = 0; s < 4; ++s) { const bf16x8 bfr = *(const bf16x8*)(KN + (16 * ct + c16) * 136 + 32 * s + 8 * q); acc = MFMA16(af[s], bfr, acc); }
                const int j = 16 * ct + c16; const float gj = s_gc[j];
#pragma unroll
                for (int r = 0; r < 4; ++r) { const int i = 16 * rt + 4 * q + r;
                    const float dec = __expf(fminf(gi[r] - gj, 0.f));
                    if (which == 0) { const float lv = (j < i) ? acc[r] * dec * bi[r] : 0.f;
                        if (ct == rt) LD[rt * 256 + (4 * q + r) * 16 + c16] = lv;
                        NB[i * 72 + 32 * (j >> 5) + pos32(j & 31)] = f2bf(ct < rt ? -lv : 0.f); }
                    else RECI[24576 + i * 64 + 32 * (j >> 5) + pos32(j & 31)] = f2bf((j <= i) ? acc[r] * dec : 0.f); }
            }
        }
        __syncthreads();
        if (wid == 0) {
            const int blk = lane >> 4, c = lane & 15;
            int ldoff = PLS + blk * 1024; asm volatile("" : "+v"(ldoff));
            const float* Lb = (const float*)(smem + ldoff);
            float t[16];
            t[0] = (c == 0) ? 1.f : 0.f;
#pragma unroll
            for (int r = 1; r < 16; ++r) { float a = (c == r) ? 1.f : 0.f;
#pragma unroll
                for (int k = 0; k < r; ++k) a -= Lb[r * 16 + k] * t[k];
                t[r] = a; }
            bf16_t* ta = TA + blk * 640 + 8 * (c >> 2) + (c & 3);
#pragma unroll
            for (int r = 0; r < 16; ++r) { ta[r * 40] = f2bf(t[r]); ta[r * 40 + 4] = 0; }
        }
        {
            { const int i = tid >> 3, seg = tid & 7, g = seg >> 1, a = seg & 1; const float eg = s_eg[i];
                const u32x4 w0 = *(const u32x4*)(QN + i * 136 + 16 * seg), w1 = *(const u32x4*)(QN + i * 136 + 16 * seg + 8);
                u32x2 o;
                o.x = pk2(bflo(w0.x) * eg, bfhi(w0.x) * eg); o.y = pk2(bflo(w0.y) * eg, bfhi(w0.y) * eg); *(u32x2*)(RECI + 8192 + i * 128 + 32 * g + 4 * a) = o;
                o.x = pk2(bflo(w0.z) * eg, bfhi(w0.z) * eg); o.y = pk2(bflo(w0.w) * eg, bfhi(w0.w) * eg); *(u32x2*)(RECI + 8192 + i * 128 + 32 * g + 8 + 4 * a) = o;
                o.x = pk2(bflo(w1.x) * eg, bfhi(w1.x) * eg); o.y = pk2(bflo(w1.y) * eg, bfhi(w1.y) * eg); *(u32x2*)(RECI + 8192 + i * 128 + 32 * g + 16 + 4 * a) = o;
                o.x = pk2(bflo(w1.z) * eg, bfhi(w1.z) * eg); o.y = pk2(bflo(w1.w) * eg, bfhi(w1.w) * eg); *(u32x2*)(RECI + 8192 + i * 128 + 32 * g + 24 + 4 * a) = o; }
            { const int k = tid >> 2, js = tid & 3, g2 = js >> 1, a = js & 1;
                float v[16];
#pragma unroll
                for (int e = 0; e < 16; ++e) v[e] = bf2f(KN[(16 * js + e) * 136 + k]) * s_ekd[16 * js + e];
#pragma unroll
                for (int qq = 0; qq < 4; ++qq) { u32x2 o; o.x = pk2(v[4 * qq], v[4 * qq + 1]); o.y = pk2(v[4 * qq + 2], v[4 * qq + 3]); *(u32x2*)(RECI + 16384 + k * 64 + 32 * g2 + 8 * qq + 4 * a) = o; } }
        }
        __syncthreads();
        {
            f32x4 X[2][4]; bf16x8 Xb[2][2];
            const bf16x8 zero8 = {0, 0, 0, 0, 0, 0, 0, 0};
#pragma unroll
            for (int tl = 0; tl < 2; ++tl) { Xb[tl][0] = zero8; Xb[tl][1] = zero8; }
#pragma unroll
            for (int I = 0; I < 4; ++I) {
                const bf16x8 ta = *(const bf16x8*)(TA + I * 640 + c16 * 40 + 8 * q);
                bf16x8 na0 = zero8, na1 = zero8;
                if (I >= 1) na0 = *(const bf16x8*)(NB + (16 * I + c16) * 72 + 8 * q);
                if (I == 3) na1 = *(const bf16x8*)(NB + (16 * I + c16) * 72 + 32 + 8 * q);
#pragma unroll
                for (int tl = 0; tl < 2; ++tl) {
                    const bf16_t* src = (tl == 0 ? VB : KN) + 16 * wid + c16; const float* scl = tl == 0 ? s_beta : s_beg;
                    f32x4 y;
#pragma unroll
                    for (int r = 0; r < 4; ++r) { const int i = 16 * I + 4 * q + r; y[r] = bf2f(src[i * 136]) * scl[i]; }
                    if (I >= 1) y = MFMA16(na0, Xb[tl][0], y);
                    if (I == 3) y = MFMA16(na1, Xb[tl][1], y);
                    u32x4 w; w.x = pk2(y[0], y[1]); w.y = pk2(y[2], y[3]); w.z = 0u; w.w = 0u;
                    const f32x4 zf = {0.f, 0.f, 0.f, 0.f};
                    X[tl][I] = MFMA16(ta, __builtin_bit_cast(bf16x8, w), zf);
                    if (I == 0) { u32x4 p; p.x = pk2(X[tl][0][0], X[tl][0][1]); p.y = pk2(X[tl][0][2], X[tl][0][3]); p.z = 0u; p.w = 0u; Xb[tl][0] = __builtin_bit_cast(bf16x8, p); }
                    if (I == 1) { u32x4 p = __builtin_bit_cast(u32x4, Xb[tl][0]); p.z = pk2(X[tl][1][0], X[tl][1][1]); p.w = pk2(X[tl][1][2], X[tl][1][3]); Xb[tl][0] = __builtin_bit_cast(bf16x8, p); }
                    if (I == 2) { u32x4 p; p.x = pk2(X[tl][2][0], X[tl][2][1]); p.y = pk2(X[tl][2][2], X[tl][2][3]); p.z = 0u; p.w = 0u; Xb[tl][1] = __builtin_bit_cast(bf16x8, p); }
                }
            }
            { unsigned char* ut = ws + WS_UT + (size_t)ridx * 16384 + (size_t)(16 * wid + c16) * 128 + 8 * q;
#pragma unroll
                for (int I = 0; I < 4; ++I) { u32x2 o; o.x = pk2(X[0][I][0], X[0][I][1]); o.y = pk2(X[0][I][2], X[0][I][3]); *(u32x2*)(ut + 32 * I) = o; } }
            { const int kc = 16 * wid + c16, pc = 32 * (kc >> 5) + pos32(kc & 31);
#pragma unroll
                for (int I = 0; I < 4; ++I)
#pragma unroll
                    for (int r = 0; r < 4; ++r) RECI[(16 * I + 4 * q + r) * 128 + pc] = f2bf(-X[1][I][r]); }
        }
        __syncthreads();
        { const u32x4* s = (const u32x4*)smem; u32x4* d = (u32x4*)(ws + WS_REC + (size_t)ridx * REC_BYTES);
#pragma unroll
            for (int e = 0; e < 7; ++e) __builtin_nontemporal_store(s[tid + 512 * e], d + tid + 512 * e); }
        __syncthreads();
    }
}

constexpr int SA_W = 0, SA_KDT = 17408, SA_SZ = 35840;
DI unsigned char* sh_base(unsigned char* ws, int grp) { return ws + (grp < 10 ? WS_R1 + 64 * MiB + (size_t)grp * 8 * MiB : WS_END + (size_t)(grp - 10) * 8 * MiB); }
DI void scan_rec(const unsigned char* imga, unsigned char* shp, unsigned char* vbp, f32x4 (&S)[8], bf16x8 (&Sb)[4], const u32x2 (&u)[4], float cd, int c16, int q) {
    const unsigned char* pw = imga + SA_W + c16 * 272 + q * 16;
    const unsigned char* pk = imga + SA_KDT + c16 * 144 + q * 16;
    bf16x8 aw[4][4], ak[8][2];
#pragma unroll
    for (int g = 0; g < 4; ++g)
#pragma unroll
        for (int m = 0; m < 4; ++m) aw[g][m] = *(const bf16x8*)(pw + m * 16 * 272 + g * 64);
#pragma unroll
    for (int m = 0; m < 8; ++m) { ak[m][0] = *(const bf16x8*)(pk + m * 16 * 144); ak[m][1] = *(const bf16x8*)(pk + m * 16 * 144 + 64); }
    __builtin_amdgcn_sched_barrier(0);
    f32x4 acc[4];
#pragma unroll
    for (int m = 0; m < 4; ++m) acc[m] = (f32x4){bflo(u[m].x), bfhi(u[m].x), bflo(u[m].y), bfhi(u[m].y)};
#pragma unroll
    for (int g = 0; g < 4; ++g) __builtin_nontemporal_store(Sb[g], (bf16x8*)(shp + g * 1024));
#pragma unroll
    for (int g = 0; g < 4; ++g) {
#pragma unroll
        for (int m = 0; m < 4; ++m) acc[m] = MFMA16(aw[g][m], Sb[g], acc[m]);
        S[2 * g] = S[2 * g] * cd; S[2 * g + 1] = S[2 * g + 1] * cd;
    }
    bf16x8 Vb[2];
#pragma unroll
    for (int g = 0; g < 2; ++g) { u32x4 w; w.x = pk2(acc[2 * g][0], acc[2 * g][1]); w.y = pk2(acc[2 * g][2], acc[2 * g][3]); w.z = pk2(acc[2 * g + 1][0], acc[2 * g + 1][1]); w.w = pk2(acc[2 * g + 1][2], acc[2 * g + 1][3]);
        Vb[g] = __builtin_bit_cast(bf16x8, w); __builtin_nontemporal_store(Vb[g], (bf16x8*)(vbp + g * 1024)); }
#pragma unroll
    for (int g = 0; g < 2; ++g)
#pragma unroll
        for (int m = 0; m < 8; ++m) S[m] = MFMA16(ak[m][g], Vb[g], S[m]);
#pragma unroll
    for (int g = 0; g < 4; ++g) { u32x4 w; w.x = pk2(S[2 * g][0], S[2 * g][1]); w.y = pk2(S[2 * g][2], S[2 * g][3]); w.z = pk2(S[2 * g + 1][0], S[2 * g + 1][1]); w.w = pk2(S[2 * g + 1][2], S[2 * g + 1][3]);
        Sb[g] = __builtin_bit_cast(bf16x8, w); }
}
DI void scan_phase(unsigned char* ws, int grp, int eighth) {
    const int tid = opaque_tid(), lane = tid & 63, wid = __builtin_amdgcn_readfirstlane(tid >> 6), c16 = lane & 15, q = lane >> 4;
    grp = opaque_s(grp); eighth = opaque_s(eighth);
    const float* CD = (const float*)(ws + WS_CD);
    const unsigned char* REC = ws + WS_REC;
    const size_t item0 = (size_t)grp * 256;
#define CLAMP255(v) ((v) < 256 ? (v) : 255)
    if (wid == 0) {
        f32x4 S[8]; bf16x8 Sb[4];
#pragma unroll
        for (int m = 0; m < 8; ++m) S[m] = (f32x4){0.f, 0.f, 0.f, 0.f};
#pragma unroll
        for (int g = 0; g < 4; ++g) Sb[g] = (bf16x8){0, 0, 0, 0, 0, 0, 0, 0};
        const unsigned char* ut = ws + WS_UT + (size_t)(16 * eighth + c16) * 128 + 8 * q;
        unsigned char* shp = sh_base(ws, grp) + (size_t)eighth * 4096 + lane * 16;
        unsigned char* vbp = ws + WS_UT + item0 * 16384 + (size_t)eighth * 2048 + lane * 16;
        u32x2 uA[4], uB[4], uC[4], uD[4]; float cdA, cdB, cdC, cdD;
#define ULOAD(U, CDV, idx) do { const size_t it_ = item0 + (size_t)(idx); _Pragma("unroll") for (int m = 0; m < 4; ++m) U[m] = *(const u32x2*)(ut + it_ * 16384 + 32 * m); CDV = CD[it_]; } while (0)
        ULOAD(uA, cdA, 0); ULOAD(uB, cdB, 1); ULOAD(uC, cdC, 2); ULOAD(uD, cdD, 3);
        __syncthreads();
        for (int n = 0; n < 256; n += 4) {
            scan_rec(smem, shp + (size_t)n * 32768, vbp + (size_t)n * 16384, S, Sb, uA, cdA, c16, q);                       ULOAD(uA, cdA, CLAMP255(n + 4)); __syncthreads();
            scan_rec(smem + SA_SZ, shp + (size_t)(n + 1) * 32768, vbp + (size_t)(n + 1) * 16384, S, Sb, uB, cdB, c16, q);   ULOAD(uB, cdB, CLAMP255(n + 5)); __syncthreads();
            scan_rec(smem, shp + (size_t)(n + 2) * 32768, vbp + (size_t)(n + 2) * 16384, S, Sb, uC, cdC, c16, q);           ULOAD(uC, cdC, CLAMP255(n + 6)); __syncthreads();
            scan_rec(smem + SA_SZ, shp + (size_t)(n + 3) * 32768, vbp + (size_t)(n + 3) * 16384, S, Sb, uD, cdD, c16, q);   ULOAD(uD, cdD, CLAMP255(n + 7)); __syncthreads();
        }
#undef ULOAD
    } else if (wid == 1) {
        u32x4 pA[4], pB[4], pC[4], pD[4];
        const unsigned char* pfb = REC + item0 * REC_BYTES + (size_t)eighth * 2048 + lane * 16;
#define PFLOAD(P, idx) do { const unsigned char* s_ = pfb + (size_t)CLAMP255(idx) * REC_BYTES; P[0] = *(const u32x4*)s_; P[1] = *(const u32x4*)(s_ + 1024); P[2] = *(const u32x4*)(s_ + 32768); P[3] = *(const u32x4*)(s_ + 33792); } while (0)
#define PFDONE(P) do { _Pragma("unroll") for (int e = 0; e < 4; ++e) asm volatile("" :: "v"(P[e])); } while (0)
        PFLOAD(pA, 6); PFLOAD(pB, 7); PFLOAD(pC, 8); PFLOAD(pD, 9);
        __syncthreads();
        for (int n = 0; n < 256; n += 4) {
            PFDONE(pA); PFLOAD(pA, n + 10); __syncthreads();
            PFDONE(pB); PFLOAD(pB, n + 11); __syncthreads();
            PFDONE(pC); PFLOAD(pC, n + 12); __syncthreads();
            PFDONE(pD); PFLOAD(pD, n + 13); __syncthreads();
        }
        PFDONE(pA); PFDONE(pB); PFDONE(pC); PFDONE(pD);
#undef PFLOAD
#undef PFDONE
    } else {
        const int lt = tid - 128;
        int offA[6], recA[6];
#pragma unroll
        for (int e = 0; e < 6; ++e) { const int ia = lt + 384 * e, o = 16 * (ia & 1023);
            if (ia < 1024) { recA[e] = o; offA[e] = SA_W + (o >> 8) * 272 + (o & 255); } else { recA[e] = 32768 + o; offA[e] = SA_KDT + (o >> 7) * 144 + (o & 127); } }
        const bool a5 = (lt + 384 * 5) < 2048;
        u32x4 ra[6], rb[6], rc[6], rd[6];
#define RLOAD(R, idx) do { const unsigned char* s_ = REC + (item0 + (size_t)(idx)) * REC_BYTES; _Pragma("unroll") for (int e = 0; e < 6; ++e) if (e < 5 || a5) R[e] = *(const u32x4*)(s_ + recA[e]); } while (0)
#define ASTORE(R, img) do { _Pragma("unroll") for (int e = 0; e < 6; ++e) if (e < 5 || a5) *(u32x4*)(smem + (img) + offA[e]) = R[e]; } while (0)
        RLOAD(ra, 0); ASTORE(ra, 0);
        RLOAD(ra, 1); RLOAD(rb, 2); RLOAD(rc, 3); RLOAD(rd, 4);
        __syncthreads();
        for (int n = 0; n < 256; n += 4) {
            ASTORE(ra, SA_SZ); RLOAD(ra, CLAMP255(n + 5)); __syncthreads();
            ASTORE(rb, 0);     RLOAD(rb, CLAMP255(n + 6)); __syncthreads();
            ASTORE(rc, SA_SZ); RLOAD(rc, CLAMP255(n + 7)); __syncthreads();
            ASTORE(rd, 0);     RLOAD(rd, CLAMP255(n + 8)); __syncthreads();
        }
#undef RLOAD
#undef ASTORE
    }
#undef CLAMP255
}
constexpr int DO_QD = 0, DO_IN = 17408, DO_OUT = 26624;
DI void dnout_phase(const float* const* in, unsigned char* ws, int layer) {
    const int tid = opaque_tid(), lane = tid & 63, wid = __builtin_amdgcn_readfirstlane(tid >> 6), c16 = lane & 15, q = lane >> 4;
    const bf16_t* ZQ = (const bf16_t*)(ws + WS_R1); bf16_t* MIX = (bf16_t*)(ws + WS_HB);
    const float* normw = in[7] + layer * 128;
    const int oi = tid >> 3, oseg = tid & 7;
    float nw[16];
#pragma unroll
    for (int e = 0; e < 16; ++e) nw[e] = normw[16 * oseg + e];
    int soff[3], roff[3];
#pragma unroll
    for (int e = 0; e < 3; ++e) { const int p = tid + 512 * e;
        if (p < 1024) { const int o = 16 * p; roff[e] = 16384 + o; soff[e] = DO_QD + (o >> 8) * 272 + (o & 255); } else { const int o = 16 * (p - 1024); roff[e] = 49152 + o; soff[e] = DO_IN + (o >> 7) * 144 + (o & 127); } }
    const int bid0 = opaque_s((int)blockIdx.x), gdim = opaque_s((int)gridDim.x);
    u32x4 pr[3], pz0, pz1; bf16x8 pSb[4], pVb[2];
#define DN_FETCH(it_) do { if ((it_) < NITEM) { const int grp_ = (it_) % 12, n_ = (it_) / 12, b_ = grp_ / 6, h_ = grp_ - 6 * b_, ridx_ = grp_ * 256 + n_, trow_ = b_ * SEQ + n_ * 64; \
        const unsigned char* rec_ = ws + WS_REC + (size_t)ridx_ * REC_BYTES; _Pragma("unroll") for (int e = 0; e < 3; ++e) pr[e] = __builtin_nontemporal_load((const u32x4*)(rec_ + roff[e])); \
        pz0 = *(const u32x4*)(ZQ + (size_t)(trow_ + oi) * 1024 + h_ * 128 + 16 * oseg); pz1 = *(const u32x4*)(ZQ + (size_t)(trow_ + oi) * 1024 + h_ * 128 + 16 * oseg + 8); \
        const unsigned char* shp_ = sh_base(ws, grp_) + (size_t)n_ * 32768 + (size_t)wid * 4096 + lane * 16; const unsigned char* vbp_ = ws + WS_UT + (size_t)ridx_ * 16384 + (size_t)wid * 2048 + lane * 16; \
        _Pragma("unroll") for (int g = 0; g < 4; ++g) pSb[g] = __builtin_nontemporal_load((const bf16x8*)(shp_ + g * 1024)); pVb[0] = __builtin_nontemporal_load((const bf16x8*)vbp_); pVb[1] = __builtin_nontemporal_load((const bf16x8*)(vbp_ + 1024)); } } while (0)
    DN_FETCH(bid0);
    for (int item = bid0; item < NITEM; item += gdim) {
        const int grp = item % 12, n = item / 12, b = grp / 6, h = grp - 6 * b, trow = b * SEQ + n * 64;
#pragma unroll
        for (int e = 0; e < 3; ++e) *(u32x4*)(smem + soff[e]) = pr[e];
        const u32x4 z0 = pz0, z1 = pz1;
        bf16x8 Sb[4], Vb[2];
#pragma unroll
        for (int g = 0; g < 4; ++g) Sb[g] = pSb[g];
        Vb[0] = pVb[0]; Vb[1] = pVb[1];
        DN_FETCH(item + gdim);
        __syncthreads();
        {
            const unsigned char* pq = smem + DO_QD + c16 * 272 + q * 16;
            const unsigned char* pi = smem + DO_IN + c16 * 144 + q * 16;
            f32x4 ao[4];
#pragma unroll
            for (int m = 0; m < 4; ++m) ao[m] = (f32x4){0.f, 0.f, 0.f, 0.f};
#pragma unroll
            for (int g = 0; g < 4; ++g) {
                bf16x8 aq[4];
#pragma unroll
                for (int m = 0; m < 4; ++m) aq[m] = *(const bf16x8*)(pq + m * 16 * 272 + g * 64);
#pragma unroll
                for (int m = 0; m < 4; ++m) ao[m] = MFMA16(aq[m], Sb[g], ao[m]);
            }
#pragma unroll
            for (int g = 0; g < 2; ++g) {
                bf16x8 ai[4];
#pragma unroll
                for (int m = 0; m < 4; ++m) ai[m] = *(const bf16x8*)(pi + m * 16 * 144 + g * 64);
#pragma unroll
                for (int m = 0; m < 4; ++m) ao[m] = MFMA16(ai[m], Vb[g], ao[m]);
            }
#pragma unroll
            for (int m = 0; m < 4; ++m)
#pragma unroll
                for (int r = 0; r < 4; ++r) *(bf16_t*)(smem + DO_OUT + (16 * m + 4 * q + r) * 272 + (16 * wid + c16) * 2) = f2bf(ao[m][r]);
        }
        __syncthreads();
        {
            const u32x4 a0 = *(const u32x4*)(smem + DO_OUT + oi * 272 + 32 * oseg), a1 = *(const u32x4*)(smem + DO_OUT + oi * 272 + 32 * oseg + 16);
            float o[16], zz[16];
            o[0] = bflo(a0.x); o[1] = bfhi(a0.x); o[2] = bflo(a0.y); o[3] = bfhi(a0.y); o[4] = bflo(a0.z); o[5] = bfhi(a0.z); o[6] = bflo(a0.w); o[7] = bfhi(a0.w);
            o[8] = bflo(a1.x); o[9] = bfhi(a1.x); o[10] = bflo(a1.y); o[11] = bfhi(a1.y); o[12] = bflo(a1.z); o[13] = bfhi(a1.z); o[14] = bflo(a1.w); o[15] = bfhi(a1.w);
            zz[0] = bflo(z0.x); zz[1] = bfhi(z0.x); zz[2] = bflo(z0.y); zz[3] = bfhi(z0.y); zz[4] = bflo(z0.z); zz[5] = bfhi(z0.z); zz[6] = bflo(z0.w); zz[7] = bfhi(z0.w);
            zz[8] = bflo(z1.x); zz[9] = bfhi(z1.x); zz[10] = bflo(z1.y); zz[11] = bfhi(z1.y); zz[12] = bflo(z1.z); zz[13] = bfhi(z1.z); zz[14] = bflo(z1.w); zz[15] = bfhi(z1.w);
            float ss = 0.f;
#pragma unroll
            for (int e = 0; e < 16; ++e) ss += o[e] * o[e];
            ss += __shfl_xor(ss, 1); ss += __shfl_xor(ss, 2); ss += __shfl_xor(ss, 4);
            const float rr = 1.f / sqrtf(ss * (1.f / 128.f) + 1e-6f);
#pragma unroll
            for (int e = 0; e < 16; ++e) o[e] = o[e] * rr * nw[e] * (zz[e] * __builtin_amdgcn_rcpf(1.f + __expf(-zz[e])));
            u32x4 w0, w1;
            w0.x = pk2(o[0], o[1]); w0.y = pk2(o[2], o[3]); w0.z = pk2(o[4], o[5]); w0.w = pk2(o[6], o[7]);
            w1.x = pk2(o[8], o[9]); w1.y = pk2(o[10], o[11]); w1.z = pk2(o[12], o[13]); w1.w = pk2(o[14], o[15]);
            bf16_t* dst = MIX + (size_t)(trow + oi) * 1024 + h * 128 + 16 * oseg;
            *(u32x4*)dst = w0; *(u32x4*)(dst + 8) = w1;
        }
        __syncthreads();
    }
}

constexpr int AT_K = 0, AT_V = 36864;
template <bool MASK>
DI void attn16(bf16x8 qb0, bf16x8 qb1, float sink, int qi, bool first_block, int g_lo, int g_hi, f32x4 (&o)[4], int c16, int q) {
    f32x4 sc[16];
    const int qt_ = __builtin_amdgcn_readfirstlane(qi >> 4);
    const unsigned char* kp = smem + AT_K + c16 * 144 + q * 16;
    const unsigned char* vp = smem + AT_V + c16 * 528 + q * 16;
    bf16x8 kb[2][8];
#pragma unroll
    for (int t = 0; t < 4; ++t) { kb[0][2 * t] = *(const bf16x8*)(kp + t * 16 * 144); kb[0][2 * t + 1] = *(const bf16x8*)(kp + t * 16 * 144 + 64); }
    __builtin_amdgcn_sched_barrier(0);
#pragma unroll
    for (int grp = 0; grp < 4; ++grp) {
        if (grp < 3) {
#pragma unroll
            for (int t = 0; t < 4; ++t) { kb[(grp + 1) & 1][2 * t] = *(const bf16x8*)(kp + (4 * (grp + 1) + t) * 16 * 144); kb[(grp + 1) & 1][2 * t + 1] = *(const bf16x8*)(kp + (4 * (grp + 1) + t) * 16 * 144 + 64); }
        }
        __builtin_amdgcn_sched_barrier(0);
        if (MASK && (grp < g_lo || grp > g_hi)) {
#pragma unroll
            for (int t = 0; t < 4; ++t) sc[4 * grp + t] = (f32x4){-1e30f, -1e30f, -1e30f, -1e30f};
        } else
#pragma unroll
        for (int t = 0; t < 4; ++t) {
            const int kt = 4 * grp + t;
            f32x4 acc = {0.f, 0.f, 0.f, 0.f};
            acc = MFMA16(kb[grp & 1][2 * t], qb0, acc); acc = MFMA16(kb[grp & 1][2 * t + 1], qb1, acc);
            if (MASK && !(kt > qt_ && kt < qt_ + 8 && (!first_block || kt >= 8))) {
#pragma unroll
                for (int r = 0; r < 4; ++r) { const int kj = 16 * kt + 4 * q + r, diff = qi + 128 - kj;
                    const bool valid = (diff >= 0) && (diff < 128) && (!first_block || kj >= 128);
                    acc[r] = valid ? acc[r] : -1e30f; }
            }
            sc[kt] = acc;
        }
        __builtin_amdgcn_sched_barrier(0);
    }
    bf16x8 vb[2][8];
#pragma unroll
    for (int gg = 0; gg < 2; ++gg)
#pragma unroll
        for (int dt = 0; dt < 4; ++dt) vb[0][4 * gg + dt] = *(const bf16x8*)(vp + dt * 16 * 528 + gg * 64);
    float m = sink;
#pragma unroll
    for (int kt = 0; kt < 16; ++kt) m = fmaxf(m, fmaxf(fmaxf(sc[kt][0], sc[kt][1]), fmaxf(sc[kt][2], sc[kt][3])));
    m = fmaxf(m, __shfl_xor(m, 16)); m = fmaxf(m, __shfl_xor(m, 32));
    float sum = 0.f;
#pragma unroll
    for (int kt = 0; kt < 16; ++kt) {
        if (MASK && ((kt >> 2) < g_lo || (kt >> 2) > g_hi)) sc[kt] = (f32x4){0.f, 0.f, 0.f, 0.f};
        else {
#pragma unroll
            for (int r = 0; r < 4; ++r) { const float pv = __expf(sc[kt][r] - m); sc[kt][r] = pv; sum += pv; } } }
    sum += __shfl_xor(sum, 16); sum += __shfl_xor(sum, 32);
    const float inv = 1.f / (sum + __expf(sink - m));
#pragma unroll
    for (int dt = 0; dt < 4; ++dt) o[dt] = (f32x4){0.f, 0.f, 0.f, 0.f};
    __builtin_amdgcn_sched_barrier(0);
#pragma unroll
    for (int grp = 0; grp < 4; ++grp) {
        if (grp < 3) {
#pragma unroll
            for (int gg = 0; gg < 2; ++gg)
#pragma unroll
                for (int dt = 0; dt < 4; ++dt) vb[(grp + 1) & 1][4 * gg + dt] = *(const bf16x8*)(vp + dt * 16 * 528 + (2 * (grp + 1) + gg) * 64);
        }
        __builtin_amdgcn_sched_barrier(0);
        if (!MASK || (grp >= g_lo && grp <= g_hi))
#pragma unroll
        for (int gg = 0; gg < 2; ++gg) { const int g = 2 * grp + gg;
            u32x4 w; w.x = pk2(sc[2 * g][0], sc[2 * g][1]); w.y = pk2(sc[2 * g][2], sc[2 * g][3]); w.z = pk2(sc[2 * g + 1][0], sc[2 * g + 1][1]); w.w = pk2(sc[2 * g + 1][2], sc[2 * g + 1][3]);
            const bf16x8 pb = __builtin_bit_cast(bf16x8, w);
#pragma unroll
            for (int dt = 0; dt < 4; ++dt) o[dt] = MFMA16(vb[grp & 1][4 * gg + dt], pb, o[dt]);
        }
        __builtin_amdgcn_sched_barrier(0);
    }
#pragma unroll
    for (int dt = 0; dt < 4; ++dt) o[dt] = o[dt] * inv;
}
DI void store_o(bf16_t* dst, const f32x4 (&o)[4], int q) {
#pragma unroll
    for (int dt = 0; dt < 4; ++dt) { u32x2 w; w.x = pk2(o[dt][0], o[dt][1]); w.y = pk2(o[dt][2], o[dt][3]); *(u32x2*)(dst + 16 * dt + 4 * q) = w; }
}
DI void memattn_phase(unsigned char* ws, int layer, int first, int stride) {
    first = opaque_s(first); stride = opaque_s(stride);
    const int tid = opaque_tid(), lane = tid & 63, wid = __builtin_amdgcn_readfirstlane(tid >> 6), c16 = lane & 15, q = lane >> 4;
    const bf16_t* KVM = (const bf16_t*)(ws + WS_KVMEM);
    const bf16_t* QP = (const bf16_t*)(ws + WS_R1);
    bf16_t* MIX = (bf16_t*)(ws + WS_HB);
    for (int item = first; item < 256; item += stride) {
        const int b = item >> 7, h = (item >> 5) & 3, rng = item & 31;
#pragma unroll
        for (int e = 0; e < 4; ++e) { const int ch = tid + 512 * e, mk = ch >> 3, c8 = ch & 7;
            const bf16_t* rowp = KVM + (size_t)(b * 256 + mk) * 2048 + layer * 512 + h * 64 + 8 * c8;
            *(u32x4*)(smem + AT_K + mk * 144 + 16 * c8) = *(const u32x4*)rowp;
            const u32x4 v = *(const u32x4*)(rowp + 256);
            const int pk = 32 * (mk >> 5) + pos32(mk & 31);
            bf16_t* vt = (bf16_t*)(smem + AT_V) + (8 * c8) * 264 + pk;
            vt[0] = (bf16_t)(v.x & 0xffffu); vt[264] = (bf16_t)(v.x >> 16); vt[2 * 264] = (bf16_t)(v.y & 0xffffu); vt[3 * 264] = (bf16_t)(v.y >> 16);
            vt[4 * 264] = (bf16_t)(v.z & 0xffffu); vt[5 * 264] = (bf16_t)(v.z >> 16); vt[6 * 264] = (bf16_t)(v.w & 0xffffu); vt[7 * 264] = (bf16_t)(v.w >> 16); }
        __syncthreads();
        u32x4 nr0, nr1;
        { const bf16_t* qp = QP + (size_t)(b * SEQ + rng * 512 + wid * 16 + c16) * 1024 + 768 + h * 64 + 8 * q; nr0 = *(const u32x4*)qp; nr1 = *(const u32x4*)(qp + 32); }
        for (int tile = wid; tile < 32; tile += 8) {
            const int tok = b * SEQ + rng * 512 + tile * 16 + c16;
            const u32x4 r0 = nr0, r1 = nr1;
            if (tile + 8 < 32) { const bf16_t* qp = QP + (size_t)(tok + 128) * 1024 + 768 + h * 64 + 8 * q; nr0 = *(const u32x4*)qp; nr1 = *(const u32x4*)(qp + 32); }
            u32x4 s0, s1;
            s0.x = pk2(bflo(r0.x) * 0.125f, bfhi(r0.x) * 0.125f); s0.y = pk2(bflo(r0.y) * 0.125f, bfhi(r0.y) * 0.125f); s0.z = pk2(bflo(r0.z) * 0.125f, bfhi(r0.z) * 0.125f); s0.w = pk2(bflo(r0.w) * 0.125f, bfhi(r0.w) * 0.125f);
            s1.x = pk2(bflo(r1.x) * 0.125f, bfhi(r1.x) * 0.125f); s1.y = pk2(bflo(r1.y) * 0.125f, bfhi(r1.y) * 0.125f); s1.z = pk2(bflo(r1.z) * 0.125f, bfhi(r1.z) * 0.125f); s1.w = pk2(bflo(r1.w) * 0.125f, bfhi(r1.w) * 0.125f);
            f32x4 o[4];
            attn16<false>(__builtin_bit_cast(bf16x8, s0), __builtin_bit_cast(bf16x8, s1), -1e30f, 0, false, 0, 3, o, c16, q);
            store_o(MIX + (size_t)tok * 1024 + 768 + h * 64, o, q);
        }
        __syncthreads();
    }
}
DI void swa_phase(const float* const* in, unsigned char* ws, int jb) {
    const int tid = opaque_tid(), lane = tid & 63, wid = __builtin_amdgcn_readfirstlane(tid >> 6), c16 = lane & 15, q = lane >> 4;
    const bf16_t* KVS = (const bf16_t*)(ws + WS_KVS);
    const bf16_t* QP = (const bf16_t*)(ws + WS_R1);
    const float* ROPE = (const float*)(ws + WS_ROPE);
    bf16_t* MIX = (bf16_t*)(ws + WS_HB);
    const float* sinks = in[9] + jb * 12;
    const int bid0 = opaque_s((int)blockIdx.x), gdim = opaque_s((int)gridDim.x);
    for (int it2 = 2 * bid0; it2 < 512; it2 += 2 * gdim)
    for (int item = it2; item < it2 + 2; ++item) {
        const int b = item >> 8, kvh = (item >> 7) & 1, blk = item & 127, t0 = b * SEQ + blk * 128;
#pragma unroll
        for (int e = 0; e < 2; ++e) { const int task = tid + 512 * e, kj = task >> 2, c = task & 3; const int t = t0 - 128 + kj;
            u32x4 o1 = {0u, 0u, 0u, 0u}, o2 = {0u, 0u, 0u, 0u};
            if (blk > 0 || kj >= 128) {
                const bf16_t* kp = KVS + (size_t)t * 256 + kvh * 64 + 8 * c;
                const u32x4 a = *(const u32x4*)kp, bq = *(const u32x4*)(kp + 32);
                const float* rp = ROPE + (size_t)t * 64 + 8 * c;
                const f32x4 c0 = *(const f32x4*)rp, c1 = *(const f32x4*)(rp + 4), s0 = *(const f32x4*)(rp + 32), s1 = *(const f32x4*)(rp + 36);
                float x1[8] = {bflo(a.x), bfhi(a.x), bflo(a.y), bfhi(a.y), bflo(a.z), bfhi(a.z), bflo(a.w), bfhi(a.w)};
                float x2[8] = {bflo(bq.x), bfhi(bq.x), bflo(bq.y), bfhi(bq.y), bflo(bq.z), bfhi(bq.z), bflo(bq.w), bfhi(bq.w)};
                float cs[8] = {c0.x, c0.y, c0.z, c0.w, c1.x, c1.y, c1.z, c1.w}, sn[8] = {s0.x, s0.y, s0.z, s0.w, s1.x, s1.y, s1.z, s1.w};
                float y1[8], y2[8];
#pragma unroll
                for (int i = 0; i < 8; ++i) { y1[i] = x1[i] * cs[i] - x2[i] * sn[i]; y2[i] = x2[i] * cs[i] + x1[i] * sn[i]; }
                o1.x = pk2(y1[0], y1[1]); o1.y = pk2(y1[2], y1[3]); o1.z = pk2(y1[4], y1[5]); o1.w = pk2(y1[6], y1[7]);
                o2.x = pk2(y2[0], y2[1]); o2.y = pk2(y2[2], y2[3]); o2.z = pk2(y2[4], y2[5]); o2.w = pk2(y2[6], y2[7]);
            }
            *(u32x4*)(smem + AT_K + kj * 144 + 16 * c) = o1; *(u32x4*)(smem + AT_K + kj * 144 + 64 + 16 * c) = o2; }
#pragma unroll
        for (int e = 0; e < 4; ++e) { const int ch = tid + 512 * e, kj = ch >> 3, c8 = ch & 7; const int t = t0 - 128 + kj;
            u32x4 v = {0u, 0u, 0u, 0u};
            if (blk > 0 || kj >= 128) v = *(const u32x4*)(KVS + (size_t)t * 256 + 128 + kvh * 64 + 8 * c8);
            const int pk = 32 * (kj >> 5) + pos32(kj & 31);
            bf16_t* vt = (bf16_t*)(smem + AT_V) + (8 * c8) * 264 + pk;
            vt[0] = (bf16_t)(v.x & 0xffffu); vt[264] = (bf16_t)(v.x >> 16); vt[2 * 264] = (bf16_t)(v.y & 0xffffu); vt[3 * 264] = (bf16_t)(v.y >> 16);
            vt[4 * 264] = (bf16_t)(v.z & 0xffffu); vt[5 * 264] = (bf16_t)(v.z >> 16); vt[6 * 264] = (bf16_t)(v.w & 0xffffu); vt[7 * 264] = (bf16_t)(v.w >> 16); }
        __syncthreads();
        u32x4 na, nb; f32x4 nc0, nc1, ns0, ns1;
#define SWA_QFETCH(task_) do { const int hh_ = (task_) >> 3, qt_ = (task_) & 7, head_ = kvh * 6 + hh_; const int tok_ = t0 + 16 * qt_ + c16; \
            const bf16_t* qp_ = QP + (size_t)tok_ * 1024 + head_ * 64 + 8 * q; na = *(const u32x4*)qp_; nb = *(const u32x4*)(qp_ + 32); \
            const float* rp_ = ROPE + (size_t)tok_ * 64 + 8 * q; nc0 = *(const f32x4*)rp_; nc1 = *(const f32x4*)(rp_ + 4); ns0 = *(const f32x4*)(rp_ + 32); ns1 = *(const f32x4*)(rp_ + 36); } while (0)
        SWA_QFETCH(wid);
        for (int task = wid; task < 48; task += 8) {
            const int hh = task >> 3, qt = task & 7, head = kvh * 6 + hh;
            const int tok = t0 + 16 * qt + c16;
            const u32x4 a = na, bq = nb; const f32x4 c0 = nc0, c1 = nc1, s0 = ns0, s1 = ns1;
            if (task + 8 < 48) SWA_QFETCH(task + 8);
            float x1[8] = {bflo(a.x), bfhi(a.x), bflo(a.y), bfhi(a.y), bflo(a.z), bfhi(a.z), bflo(a.w), bfhi(a.w)};
            float x2[8] = {bflo(bq.x), bfhi(bq.x), bflo(bq.y), bfhi(bq.y), bflo(bq.z), bfhi(bq.z), bflo(bq.w), bfhi(bq.w)};
            float cs[8] = {c0.x, c0.y, c0.z, c0.w, c1.x, c1.y, c1.z, c1.w}, sn[8] = {s0.x, s0.y, s0.z, s0.w, s1.x, s1.y, s1.z, s1.w};
            float y1[8], y2[8];
#pragma unroll
            for (int i = 0; i < 8; ++i) { y1[i] = (x1[i] * cs[i] - x2[i] * sn[i]) * 0.125f; y2[i] = (x2[i] * cs[i] + x1[i] * sn[i]) * 0.125f; }
            u32x4 o1, o2;
            o1.x = pk2(y1[0], y1[1]); o1.y = pk2(y1[2], y1[3]); o1.z = pk2(y1[4], y1[5]); o1.w = pk2(y1[6], y1[7]);
            o2.x = pk2(y2[0], y2[1]); o2.y = pk2(y2[2], y2[3]); o2.z = pk2(y2[4], y2[5]); o2.w = pk2(y2[6], y2[7]);
            f32x4 o[4];
            attn16<true>(__builtin_bit_cast(bf16x8, o1), __builtin_bit_cast(bf16x8, o2), sinks[head], 16 * qt + c16, blk == 0, blk == 0 ? 2 : (qt >> 2), (qt + 8) >> 2, o, c16, q);
            store_o(MIX + (size_t)tok * 1024 + head * 64, o, q);
        }
#undef SWA_QFETCH
        __syncthreads();
    }
}

#define XB_TMO      128
#define XB_XCNT(j)  (256  + 64 * (j))
#define XB_XSUB(j)  (1280 + 64 * (j))
#define XB_XGEN(j)  (2304 + 64 * (j))
#define XB_TOP      3328
#define XB_TOPGEN   3392
#define XCD_BAR_WORDS 3456
#define XB_SPIN_CAP (1u << 18)
#define LAS __attribute__((address_space(3)))

__device__ __forceinline__ unsigned xb_ld(unsigned* p)              { return __hip_atomic_load(p, __ATOMIC_RELAXED, __HIP_MEMORY_SCOPE_AGENT); }
__device__ __forceinline__ unsigned xb_add(unsigned* p, unsigned v) { return __hip_atomic_fetch_add(p, v, __ATOMIC_RELAXED, __HIP_MEMORY_SCOPE_AGENT); }
__device__ __forceinline__ unsigned xb_xcc_id() { return (unsigned)__builtin_amdgcn_s_getreg((3 << 11) | 20) & 0xFu; }
#define XB_SPIN(cond, bar) do { unsigned _sp = 0; while (cond) { __builtin_amdgcn_s_sleep(1); \
    if ((++_sp & 255u) == 0u) { if (xb_ld(&(bar)[XB_TMO])) break; if (_sp > XB_SPIN_CAP) { atomicAdd(&(bar)[XB_TMO], 1u); break; } } } } while (0)

struct XcdBarrier {
    unsigned* bar; unsigned x;
    volatile LAS unsigned* st;
};

__device__ __forceinline__ XcdBarrier xcd_barrier_post(unsigned* bar, volatile LAS unsigned* st) {
    XcdBarrier b; b.bar = bar; b.x = xb_xcc_id(); b.st = st;
    if (threadIdx.x == 0) (void)xb_add(&bar[XB_XCNT(b.x)], 1u);
    return b;
}
__device__ __forceinline__ void xcd_barrier_complete(unsigned* bar, unsigned x, unsigned& nloc, unsigned& nx) {
    const unsigned G = gridDim.x * gridDim.y * gridDim.z;
    unsigned sum, cnt, mine, sp = 0u;
    for (;;) {
        sum = 0u; cnt = 0u; mine = 0u;
#pragma unroll
        for (unsigned j = 0; j < 16; ++j) { const unsigned c = xb_ld(&bar[XB_XCNT(j)]); sum += c; cnt += (c > 0u) ? 1u : 0u; mine = (j == x) ? c : mine; }
        if (sum == G) break;
        __builtin_amdgcn_s_sleep(1);
        if ((++sp & 255u) == 0u) { if (xb_ld(&bar[XB_TMO])) break; if (sp > XB_SPIN_CAP) { atomicAdd(&bar[XB_TMO], 1u); break; } }
    }
    nloc = mine > 0u ? mine : 1u; nx = cnt > 0u ? cnt : 1u;
}

__device__ __forceinline__ void xcd_barrier(const XcdBarrier& b) {
    asm volatile("s_waitcnt vmcnt(0)" ::: "memory");
    __syncthreads();
    if (threadIdx.x == 0) {
        unsigned* bar = b.bar;
        __builtin_amdgcn_s_waitcnt(0);
        unsigned nloc = b.st[0], nx = b.st[1];
        if (nloc == 0u) { xcd_barrier_complete(bar, b.x, nloc, nx); b.st[0] = nloc; b.st[1] = nx; }
        const unsigned old = xb_add(&bar[XB_XSUB(b.x)], 1u);
        const unsigned gen = old / nloc;
        if (old + 1u == (gen + 1u) * nloc) {
            __builtin_amdgcn_fence(__ATOMIC_RELEASE, "agent");
            asm volatile("s_waitcnt vmcnt(0)" ::: "memory");
            const unsigned og = xb_add(&bar[XB_TOP], 1u);
            const unsigned tg = og / nx;
            if (og + 1u == (tg + 1u) * nx) xb_add(&bar[XB_TOPGEN], 1u);
            else XB_SPIN(xb_ld(&bar[XB_TOPGEN]) == tg, bar);
            __builtin_amdgcn_fence(__ATOMIC_ACQUIRE, "agent");
            xb_add(&bar[XB_XGEN(b.x)], 1u);
            asm volatile("s_waitcnt vmcnt(0)" ::: "memory");
        } else {
            XB_SPIN(xb_ld(&bar[XB_XGEN(b.x)]) == gen, bar);
            __builtin_amdgcn_fence(__ATOMIC_ACQUIRE, "agent");
            asm volatile("s_waitcnt vmcnt(0)" ::: "memory");
        }
    }
    __syncthreads();
}


struct Params { const float* in[17]; float* out; unsigned char* ws; int ph_lo, ph_hi; };
template <class Epi> DI void run_gemm(const bf16_t* A, const bf16_t* Bt, int M, int N, int K, const Epi& E) {
    pg8::Gemm g{A, Bt, M, N, K}; pg8::StaticOrder S; S.init(M, N, opaque_s((int)gridDim.x), opaque_s((int)blockIdx.x));
    pg8::gemm_phase<Epi, pg8::StaticOrder, false>((PG8_LAS unsigned char*)smem, g, S, E, nullptr);
}
template <class Epi> DI void run_gemm_sub(const bf16_t* A, const bf16_t* Bt, int M, int N, int K, const Epi& E, int G, int c) {
    pg8::Gemm g{A, Bt, M, N, K}; pg8::StaticOrder S; S.init(M, N, opaque_s(G), opaque_s(c));
    pg8::gemm_phase<Epi, pg8::StaticOrder, false>((PG8_LAS unsigned char*)smem, g, S, E, nullptr);
}
__global__ void __launch_bounds__(512, 2) yoco_fwd(Params p) {
    cg::grid_group grid = cg::this_grid();
    __shared__ uint4 xb_words;
    if (threadIdx.x == 0) xb_words = make_uint4(0u, 0u, 0u, 0u);
    __syncthreads();
    const XcdBarrier xbar = xcd_barrier_post((unsigned*)p.ws, (volatile LAS unsigned*)&xb_words);
    int ph = 0;
#define PHASE_BEGIN if (ph >= p.ph_lo && ph < p.ph_hi) { unsigned char* ws = opaque_ptr(p.ws); bf16_t* HB = (bf16_t*)(ws + WS_HB); const int tid = opaque_tid(), lane = tid & 63, wid = __builtin_amdgcn_readfirstlane(tid >> 6); const int gw = opaque_s((int)blockIdx.x) * 8 + wid, ngw = opaque_s((int)gridDim.x) * 8; float* scr = (float*)smem + wid * (64 * 33); (void)HB; (void)gw; (void)ngw; (void)scr; (void)lane;
#define PHASE_END   if (ph + 1 < p.ph_hi) { if (p.ph_lo < 0) grid.sync();   xcd_barrier(xbar); } } ++ph;
    PHASE_BEGIN
        row_pass<false, false, true>(p.in[0], nullptr, HB, nullptr, nullptr, p.in[3], (float*)(ws + WS_AB), gw, ngw, lane);
        __syncthreads();
        convert_small_weights(p.in, ws, 0, gw, ngw, lane, scr);
        for (int i = gw * 64 + lane; i < T * 32; i += ngw * 64) { const int t = i >> 5, f = i & 31;
            const float invf = exp2f(-(float)f * (13.287712379549449f / 32.f));
            const float ang = (float)((const int*)p.in[2])[t] * invf;
            double rev = (double)ang * 0.15915494309189535; rev -= __builtin_rint(rev);
            const float rv = (float)rev;
            float* rp = (float*)(ws + WS_ROPE) + (size_t)t * 64 + f; rp[0] = __builtin_amdgcn_cosf(rv); rp[32] = __builtin_amdgcn_sinf(rv); }
        for (int i = gw * 64 + lane; i < 512 * 1024 / 4; i += ngw * 64) { const f32x4 v = ((const f32x4*)p.in[1])[i]; u32x2 w; w.x = pk2(v.x, v.y); w.y = pk2(v.z, v.w); ((u32x2*)(ws + WS_MEMB))[i] = w; }
    PHASE_END
#pragma unroll 1
    for (int layer = 0; layer < 4; ++layer) {
        const bool isA = layer < 2;
        if (isA) {
            PHASE_BEGIN
                run_gemm(HB, (const bf16_t*)(ws + WS_WA1) + (size_t)layer * 2304 * 1024, T, 2304, 1024, pg8::EpiBf16<0>{(bf16_t*)(ws + WS_R1), 2304});
                if (layer == 0) run_gemm_sub((const bf16_t*)(ws + WS_MEMB), (const bf16_t*)(ws + WS_WMKV), 512, 2048, 1024, pg8::EpiBf16<0>{(bf16_t*)(ws + WS_KVMEM), 2048}, (int)gridDim.x, (int)((blockIdx.x + gridDim.x / 2) % gridDim.x));
            PHASE_END
            PHASE_BEGIN
                prep_phase(p.in, ws, layer);
            PHASE_END
            PHASE_BEGIN
                {
                    const int bid = opaque_s((int)blockIdx.x), x = bid & 7, k = bid >> 3;
                    int grp = -1, eighth = 0, midx = bid - 96;
                    if (bid < 128) { if (x < 4) { grp = 2 * x + (k >> 3); eighth = k & 7; } else if (k < 8) { grp = 8 + (x - 4); eighth = k; } else midx = (x - 4) * 8 + (k - 8); }
                    if (grp >= 0) scan_phase(ws, grp, eighth);
                    else { run_gemm_sub(HB, (const bf16_t*)(ws + WS_WA2) + (size_t)layer * 1024 * 1024, T, 1024, 1024, pg8::EpiBf16<0>{(bf16_t*)(ws + WS_R1), 1024}, (int)gridDim.x - 96, midx);
                        const int gw2 = midx * 8 + wid, ngw2 = ((int)gridDim.x - 96) * 8;
                        if (layer == 0) convert_small_weights(p.in, ws, 1, gw2, ngw2, lane, scr);
                        convert_mlp_weights(p.in, ws, layer, gw2, ngw2, lane, scr); }
                }
            PHASE_END
            PHASE_BEGIN
                dnout_phase(p.in, ws, layer);
                memattn_phase(ws, layer, blockIdx.x, gridDim.x);
            PHASE_END
        } else {
            PHASE_BEGIN
                run_gemm(HB, (const bf16_t*)(ws + WS_WB1) + (size_t)(layer - 2) * 1024 * 1024, T, 1024, 1024, pg8::EpiBf16<0>{(bf16_t*)(ws + WS_R1), 1024});
                if (layer == 2) run_gemm(HB, (const bf16_t*)(ws + WS_WKV), T, 256, 1024, pg8::EpiBf16<0>{(bf16_t*)(ws + WS_KVS), 256});
            PHASE_END
            PHASE_BEGIN
                swa_phase(p.in, ws, layer - 2);
                memattn_phase(ws, layer, blockIdx.x, gridDim.x);
            PHASE_END
        }
        PHASE_BEGIN
            run_gemm(HB, (const bf16_t*)(ws + WS_WO) + (size_t)layer * 1024 * 1024, T, 1024, 1024, pg8::EpiRes{layer == 0 ? p.in[0] : p.out, p.out, DN_ALPHA});
        PHASE_END
        PHASE_BEGIN
            row_pass<true, false, true>(p.out, nullptr, HB, p.in[15] + (size_t)(layer * 2) * 1024, p.in[16] + (size_t)(layer * 2) * 1024, nullptr, nullptr, gw, ngw, lane);
        PHASE_END
        PHASE_BEGIN
            run_gemm(HB, (const bf16_t*)(ws + WS_WUP), T, 4096, 1024, pg8::EpiBf16<3>{(bf16_t*)(ws + WS_R1), 4096});
        PHASE_END
        PHASE_BEGIN
            run_gemm((const bf16_t*)(ws + WS_R1), (const bf16_t*)(ws + WS_WDN), T, 1024, 4096, pg8::EpiResB{HB, p.out, DN_ALPHA});
        PHASE_END
        PHASE_BEGIN
            if (layer >= 1 && layer < 3) convert_mlp_weights(p.in, ws, layer + 1, gw, ngw, lane, scr);
            if (layer == 3) row_pass<true, true, false>(p.out, p.out, nullptr, p.in[15] + (size_t)(layer * 2 + 1) * 1024, p.in[16] + (size_t)(layer * 2 + 1) * 1024, nullptr, nullptr, gw, ngw, lane);
            else row_pass<true, true, true>(p.out, p.out, HB, p.in[15] + (size_t)(layer * 2 + 1) * 1024, p.in[16] + (size_t)(layer * 2 + 1) * 1024,
                                            layer == 0 ? p.in[3] + (size_t)1024 * 3340 : nullptr, (float*)(ws + WS_AB), gw, ngw, lane);
        PHASE_END
    }
}

extern "C" void kernel_launch(void* const* d_in, const int* in_sizes, int n_in, void* d_out, int out_size, void* d_ws, size_t ws_size, hipStream_t stream) {
    static int grid = 0;
    if (grid == 0) {
        int dev = 0, cus = 0, per_cu = 0;
        hipGetDevice(&dev); hipDeviceGetAttribute(&cus, hipDeviceAttributeMultiprocessorCount, dev);
        if (hipFuncSetAttribute((const void*)yoco_fwd, hipFuncAttributeMaxDynamicSharedMemorySize, LDS_BYTES) != hipSuccess) fprintf(stderr, "kernel_launch: hipFuncSetAttribute failed\n");
        if (hipOccupancyMaxActiveBlocksPerMultiprocessor(&per_cu, (const void*)yoco_fwd, 512, LDS_BYTES) != hipSuccess || per_cu < 1) { fprintf(stderr, "kernel_launch: occupancy query says %d\n", per_cu); per_cu = 1; }
        (void)hipGetLastError();
        grid = cus * 1;
        if (ws_size < WS_END + 16 * MiB) fprintf(stderr, "kernel_launch: workspace too small: %zu < %zu\n", ws_size, (size_t)WS_END);
        if (n_in != 17) fprintf(stderr, "kernel_launch: expected 17 inputs, got %d\n", n_in);
    }
    Params p{};
    for (int i = 0; i < 17; ++i) p.in[i] = (const float*)d_in[i];
    p.out = (float*)d_out; p.ws = (unsigned char*)d_ws; p.ph_lo = 0; p.ph_hi = 1000;
    if (hipMemsetAsync(d_ws, 0, XCD_BAR_WORDS * 4, stream) != hipSuccess) fprintf(stderr, "kernel_launch: memset failed\n");
    void* args[] = {&p};
    hipError_t e = hipLaunchCooperativeKernel((const void*)yoco_fwd, dim3(grid), dim3(512), args, LDS_BYTES, stream);
    if (e != hipSuccess) fprintf(stderr, "cooperative launch failed: %s (grid %d)\n", hipGetErrorString(e), grid);
}
```
